# Optimizing an MI355X kernel written in HIP

```python
import jax, jax.numpy as jnp
from jax import lax
import numpy as np

D_MODEL = 1024
BATCH = 8
SEQ = 4096
DEPTH = 4

LRU_WIDTH = D_MODEL
LRU_HEADS = 8
LRU_BLOCK = LRU_WIDTH // LRU_HEADS
CONV_WIDTH = 4
CONV_LEFT = 2
LRU_C = 8.0
SG_WIDTH = D_MODEL
SG_GROUPS = 8
SG_GROUP_DIM = SG_WIDTH // SG_GROUPS
SG_CHUNK = 128
EVEN_IN = 2 * LRU_WIDTH + 2 * SG_WIDTH
EVEN_MIX = LRU_WIDTH + SG_WIDTH
N_Q_HEADS = 16
N_KV_HEADS = 4
Q_PER_KV = N_Q_HEADS // N_KV_HEADS
HEAD_DIM = 64
WINDOW = 128
ATTN_BLOCK = 128
ATTN_SPAN = ATTN_BLOCK + 2 * WINDOW
QKV_WIDTH = (N_Q_HEADS + 2 * N_KV_HEADS) * HEAD_DIM
ROPE_THETA = 10000.0
D_FF = -(-8 * D_MODEL // (3 * 256)) * 256
N_EVEN = (DEPTH + 1) // 2
N_ODD = DEPTH // 2
EPS = 1e-6
NEG_INF = -1e30

kernel_name = "hybrid_rglru_gmlp_swa_encoder"


def rmsnorm(x, g):
    xf = x.astype(jnp.float32)
    y = xf * lax.rsqrt(jnp.mean(xf * xf, axis=-1, keepdims=True) + EPS)
    return (y * g.astype(jnp.float32)).astype(x.dtype)


def layernorm(x, g, b):
    xf = x.astype(jnp.float32)
    mu = jnp.mean(xf, axis=-1, keepdims=True)
    var = jnp.mean(jnp.square(xf - mu), axis=-1, keepdims=True)
    y = (xf - mu) * lax.rsqrt(var + EPS)
    return (y * g.astype(jnp.float32) + b.astype(jnp.float32)).astype(x.dtype)


def rope(x, positions):
    half = x.shape[-1] // 2
    freqs = ROPE_THETA ** (-jnp.arange(half, dtype=jnp.float32) * 2.0 / x.shape[-1])
    ang = positions.astype(jnp.float32)[:, None] * freqs[None, :]
    cos = jnp.cos(ang)[None, :, None, :]
    sin = jnp.sin(ang)[None, :, None, :]
    xf = x.astype(jnp.float32)
    x1, x2 = xf[..., :half], xf[..., half:]
    out = jnp.concatenate([x1 * cos - x2 * sin, x2 * cos + x1 * sin], axis=-1)
    return out.astype(x.dtype)


def centred_depthwise_conv(x, w, b):
    S = x.shape[1]
    xp = jnp.pad(x, ((0, 0), (CONV_LEFT, CONV_WIDTH - 1 - CONV_LEFT), (0, 0)))
    y = b
    for k in range(CONV_WIDTH):
        y = y + xp[:, k:k + S, :] * w[k]
    return y


def rglru_scan(x, w_r, b_r, w_i, b_i, lam, reverse):
    B, S, W = x.shape
    xh = x.reshape(B, S, LRU_HEADS, LRU_BLOCK)
    f32 = jnp.float32
    r = jax.nn.sigmoid(jnp.einsum('bshi,hij->bshj', xh, w_r.astype(f32)).reshape(B, S, W) + b_r.astype(f32))
    i = jax.nn.sigmoid(jnp.einsum('bshi,hij->bshj', xh, w_i.astype(f32)).reshape(B, S, W) + b_i.astype(f32))
    log_a = -LRU_C * r * jax.nn.softplus(-lam.astype(f32))
    a = jnp.exp(log_a)
    mult = jnp.sqrt(jnp.maximum(-jnp.expm1(2.0 * log_a), 0.0))
    u = mult * (i * x)

    def combine(c1, c2):
        a1, b1 = c1
        a2, b2 = c2
        return a1 * a2, a2 * b1 + b2

    _, h = lax.associative_scan(combine, (a, u), reverse=reverse, axis=1)
    return h


def even_mixer(h, w_in, conv_w, conv_b, w_r, b_r, w_i, b_i, lam, ln_g, ln_b, sg_w, sg_b, w_out):
    B, S, _ = h.shape
    proj = h @ w_in
    xa, ga, zu, zv = jnp.split(proj, [LRU_WIDTH, 2 * LRU_WIDTH, 2 * LRU_WIDTH + SG_WIDTH], axis=-1)
    xa = centred_depthwise_conv(xa, conv_w, conv_b).astype(jnp.float32)
    h_fwd = rglru_scan(xa, w_r[0], b_r[0], w_i[0], b_i[0], lam[0], reverse=False)
    h_bwd = rglru_scan(xa, w_r[1], b_r[1], w_i[1], b_i[1], lam[1], reverse=True)
    y_a = jax.nn.gelu(ga) * (h_fwd + h_bwd).astype(h.dtype)
    u = jax.nn.gelu(zu)
    v = layernorm(jax.nn.gelu(zv), ln_g, ln_b)
    n_chunks = S // SG_CHUNK
    vc = v.reshape(B, n_chunks, SG_CHUNK, SG_GROUPS, SG_GROUP_DIM)
    sv = jnp.einsum('gpq,bcqgd->bcpgd', sg_w, vc) + jnp.transpose(sg_b)[None, None, :, :, None]
    y_b = u * sv.reshape(B, S, SG_WIDTH)
    return jnp.concatenate([y_a, y_b], axis=-1) @ w_out


def windowed_gqa(h, w_qkv, sinks, w_o):
    B, S, _ = h.shape
    positions = jnp.arange(S)
    qkv = h @ w_qkv
    q, k, v = jnp.split(qkv, [N_Q_HEADS * HEAD_DIM, (N_Q_HEADS + N_KV_HEADS) * HEAD_DIM], axis=-1)
    q = rope(q.reshape(B, S, N_Q_HEADS, HEAD_DIM), positions) * (HEAD_DIM ** -0.5)
    k = rope(k.reshape(B, S, N_KV_HEADS, HEAD_DIM), positions)
    v = v.reshape(B, S, N_KV_HEADS, HEAD_DIM)
    n_blocks = S // ATTN_BLOCK
    kp = jnp.pad(k, ((0, 0), (WINDOW, WINDOW), (0, 0), (0, 0)))
    vp = jnp.pad(v, ((0, 0), (WINDOW, WINDOW), (0, 0), (0, 0)))
    qb = q.reshape(B, n_blocks, ATTN_BLOCK, N_KV_HEADS, Q_PER_KV, HEAD_DIM).transpose(1, 0, 2, 3, 4, 5)
    sink = sinks.astype(jnp.float32).reshape(N_KV_HEADS, Q_PER_KV)

    def block(args):
        idx, qi = args
        start = idx * ATTN_BLOCK
        ki = lax.dynamic_slice_in_dim(kp, start, ATTN_SPAN, axis=1)
        vi = lax.dynamic_slice_in_dim(vp, start, ATTN_SPAN, axis=1)
        s = jnp.einsum('btkgd,bskd->bkgts', qi, ki).astype(jnp.float32)
        qpos = start + jnp.arange(ATTN_BLOCK)
        kpos = start - WINDOW + jnp.arange(ATTN_SPAN)
        valid = (jnp.abs(qpos[:, None] - kpos[None, :]) <= WINDOW) & (kpos >= 0)[None, :] & (kpos < S)[None, :]
        s = jnp.where(valid, s, NEG_INF)
        sink_col = jnp.broadcast_to(sink[None, :, :, None, None], s.shape[:-1] + (1,))
        p = jax.nn.softmax(jnp.concatenate([s, sink_col], axis=-1), axis=-1)[..., :ATTN_SPAN]
        return jnp.einsum('bkgts,bskd->btkgd', p.astype(vi.dtype), vi)

    out = lax.map(block, (jnp.arange(n_blocks), qb))
    out = out.transpose(1, 0, 2, 3, 4, 5).reshape(B, S, N_Q_HEADS * HEAD_DIM)
    return out @ w_o


def swiglu(h, w_gu, w_down):
    g, u = jnp.split(h @ w_gu, 2, axis=-1)
    return (jax.nn.silu(g) * u) @ w_down


def setup_inputs(seed: int = 0) -> dict:
    key = jax.random.key(seed)
    ks = jax.random.split(key, 24)
    nrm = jax.random.normal
    f32 = jnp.float32
    u = jax.random.uniform(ks[11], (N_EVEN, 2, LRU_WIDTH), f32, 0.9, 0.999)
    a0 = u ** (1.0 / LRU_C)
    return {
        "x": nrm(ks[0], (BATCH, SEQ, D_MODEL), f32),
        "mix_norm": 1.0 + 0.01 * nrm(ks[1], (DEPTH, D_MODEL), f32),
        "ffn_norm": 1.0 + 0.01 * nrm(ks[2], (DEPTH, D_MODEL), f32),
        "final_norm": 1.0 + 0.01 * nrm(ks[3], (D_MODEL,), f32),
        "even_w_in": nrm(ks[4], (N_EVEN, D_MODEL, EVEN_IN), f32) * D_MODEL ** -0.5,
        "even_conv_w": nrm(ks[5], (N_EVEN, CONV_WIDTH, LRU_WIDTH), f32) * CONV_WIDTH ** -0.5,
        "even_conv_b": 0.01 * nrm(ks[6], (N_EVEN, LRU_WIDTH), f32),
        "lru_w_r": nrm(ks[7], (N_EVEN, 2, LRU_HEADS, LRU_BLOCK, LRU_BLOCK), f32) * LRU_BLOCK ** -0.5,
        "lru_b_r": 0.01 * nrm(ks[8], (N_EVEN, 2, LRU_WIDTH), f32),
        "lru_w_i": nrm(ks[9], (N_EVEN, 2, LRU_HEADS, LRU_BLOCK, LRU_BLOCK), f32) * LRU_BLOCK ** -0.5,
        "lru_b_i": 0.01 * nrm(ks[10], (N_EVEN, 2, LRU_WIDTH), f32),
        "lru_lambda": jnp.log(a0) - jnp.log1p(-a0),
        "sg_ln_g": 1.0 + 0.01 * nrm(ks[12], (N_EVEN, SG_WIDTH), f32),
        "sg_ln_b": 0.01 * nrm(ks[13], (N_EVEN, SG_WIDTH), f32),
        "sg_w": nrm(ks[14], (N_EVEN, SG_GROUPS, SG_CHUNK, SG_CHUNK), f32) * SG_CHUNK ** -0.5,
        "sg_b": 1.0 + 0.01 * nrm(ks[15], (N_EVEN, SG_GROUPS, SG_CHUNK), f32),
        "even_w_out": nrm(ks[16], (N_EVEN, EVEN_MIX, D_MODEL), f32) * EVEN_MIX ** -0.5,
        "attn_w_qkv": nrm(ks[17], (N_ODD, D_MODEL, QKV_WIDTH), f32) * D_MODEL ** -0.5,
        "attn_sinks": 0.5 * nrm(ks[18], (N_ODD, N_Q_HEADS), f32),
        "attn_w_o": nrm(ks[19], (N_ODD, N_Q_HEADS * HEAD_DIM, D_MODEL), f32) * (N_Q_HEADS * HEAD_DIM) ** -0.5,
        "ffn_w_gu": nrm(ks[20], (DEPTH, D_MODEL, 2 * D_FF), f32) * D_MODEL ** -0.5,
        "ffn_w_down": nrm(ks[21], (DEPTH, D_FF, D_MODEL), f32) * D_FF ** -0.5,
    }


def reference(x, mix_norm, ffn_norm, final_norm, even_w_in, even_conv_w, even_conv_b,
              lru_w_r, lru_b_r, lru_w_i, lru_b_i, lru_lambda, sg_ln_g, sg_ln_b, sg_w, sg_b,
              even_w_out, attn_w_qkv, attn_sinks, attn_w_o, ffn_w_gu, ffn_w_down):
    for layer in range(DEPTH):
        j = layer // 2
        hn = rmsnorm(x, mix_norm[layer])
        if layer % 2 == 0:
            x = x + even_mixer(hn, even_w_in[j], even_conv_w[j], even_conv_b[j],
                               lru_w_r[j], lru_b_r[j], lru_w_i[j], lru_b_i[j], lru_lambda[j],
                               sg_ln_g[j], sg_ln_b[j], sg_w[j], sg_b[j], even_w_out[j])
        else:
            x = x + windowed_gqa(hn, attn_w_qkv[j], attn_sinks[j], attn_w_o[j])
        x = x + swiglu(rmsnorm(x, ffn_norm[layer]), ffn_w_gu[layer], ffn_w_down[layer])
    return rmsnorm(x, final_norm)
```

```cpp
#include <hip/hip_runtime.h>
#include <hip/hip_cooperative_groups.h>
#include <cstdio>
#include <cstdint>
namespace cg = cooperative_groups;


#define LAS __attribute__((address_space(3)))
typedef unsigned short bf16_t;
typedef short bf16x8 __attribute__((ext_vector_type(8)));
typedef float f32x4 __attribute__((ext_vector_type(4)));
typedef float f32x2 __attribute__((ext_vector_type(2)));
typedef unsigned u32x4 __attribute__((ext_vector_type(4)));
typedef unsigned u32x2 __attribute__((ext_vector_type(2)));

constexpr int BATCH = 8, SEQ = 4096, DM = 1024, MTOK = BATCH * SEQ;
constexpr int NIN = 4096, NQKV = 1536, DFF = 2816, NGU = 5632, KOUT = 2048;
constexpr float EPS = 1e-6f;
constexpr int NPHASE = 24;

constexpr size_t MiB = 1u << 20;
constexpr size_t OFF_WIN = 0, OFF_WOUT = 16 * MiB, OFF_WQKV = 24 * MiB, OFF_WO = 30 * MiB, OFF_WGU = 34 * MiB, OFF_WDN = 78 * MiB;
constexpr size_t OFF_WG = 100 * MiB, OFF_WSG = 102 * MiB, OFF_ROPE = 103 * MiB, OFF_SS = 104 * MiB, OFF_AGG = 106 * MiB, OFF_XB = 114 * MiB, OFF_R1 = 178 * MiB;
constexpr size_t OFF_SSP = 434 * MiB;
constexpr size_t WS_NEED = 454 * MiB;
constexpr int MISC_OFF = 152576 + 8192;
constexpr int LDS_BYTES = MISC_OFF + 16;
constexpr size_t OFF_BAR = 104 * MiB;

__device__ __forceinline__ unsigned cvt_pk_bf16(float lo, float hi) { unsigned r; asm("v_cvt_pk_bf16_f32 %0, %1, %2" : "=v"(r) : "v"(lo), "v"(hi)); return r; }
__device__ __forceinline__ float bf2f(unsigned short b) { return __uint_as_float(((unsigned)b) << 16); }
__device__ __forceinline__ float bflo(unsigned w) { return __uint_as_float(w << 16); }
__device__ __forceinline__ float bfhi(unsigned w) { return __uint_as_float(w & 0xffff0000u); }
__device__ __forceinline__ float gelu_t(float x) { const float t = x * (1.f + 0.044715f * x * x) * (-2.f * 0.7978845608f * 1.4426950409f); return x * __builtin_amdgcn_rcpf(1.f + __builtin_amdgcn_exp2f(t)); }
__device__ __forceinline__ float sigm(float x) { return __builtin_amdgcn_rcpf(1.f + __builtin_amdgcn_exp2f(-1.4426950409f * x)); }
__device__ __forceinline__ float silu_f(float x) { return x * sigm(x); }
__device__ __forceinline__ void sigm8(f32x4& a, f32x4& b, float scale) {
    a = a * scale; b = b * scale;
#pragma unroll
    for (int j = 0; j < 4; ++j) { a[j] = __builtin_amdgcn_exp2f(a[j]); b[j] = __builtin_amdgcn_exp2f(b[j]); }
    a = a + 1.f; b = b + 1.f;
#pragma unroll
    for (int j = 0; j < 4; ++j) { a[j] = __builtin_amdgcn_rcpf(a[j]); b[j] = __builtin_amdgcn_rcpf(b[j]); }
}
__device__ __forceinline__ float wave_sum(float v) {
#pragma unroll
    for (int o = 1; o < 64; o <<= 1) v += __shfl_xor(v, o);
    return v;
}

__device__ __forceinline__ float row_rs(const float* ssp, int row) {
    const f32x4* q = (const f32x4*)(ssp + (size_t)row * 16); const f32x4 a = q[0], b = q[1], c = q[2], d = q[3];
    const float s = ((a[0] + a[1]) + (a[2] + a[3])) + ((b[0] + b[1]) + (b[2] + b[3])) + (((c[0] + c[1]) + (c[2] + c[3])) + ((d[0] + d[1]) + (d[2] + d[3])));
    return rsqrtf(s * (1.f / DM) + EPS);
}

namespace pg8 {
constexpr int BM = 256, BK = 64, HALF = 128, HTB = HALF * BK * 2, STAGE_BYTES = 8 * HTB, NXCD = 8, WGM = 8;
__host__ __device__ __forceinline__ int lds_byte(int r, int c) { const int st = (r >> 4) * 2 + (c >> 5), rr = r & 15, cc = c & 31, ob = rr * 64 + cc * 2; return st * 1024 + (ob ^ (((ob >> 9) & 1) << 5)); }
__host__ __device__ __forceinline__ void stage_rc(int b, int& R, int& C) { const int st = b / 1024, sb = b % 1024, swz = sb ^ (((sb >> 9) & 1) << 5); R = (st >> 1) * 16 + swz / 64; C = (st & 1) * 32 + (swz % 64) / 2; }
struct Unit { int pm, pn; };
struct Gemm { const bf16_t* A; const bf16_t* Bt; int M, N, K, lda; };
struct StaticOrder {
    int nM, nN, nwg, G, c;
    __device__ void init(int M, int N, int G_, int c_) { nM = M / BM; nN = N / BM; nwg = nM * nN; G = G_; c = c_; }
    __device__ bool next(int i, Unit& u) const {
        const long L = (long)i * G + c; if (L >= nwg) return false;
        int wgid = (int)L; { const int q = nwg / NXCD, r = nwg % NXCD, xcd = wgid % NXCD, off = wgid / NXCD; wgid = (xcd < r ? xcd * (q + 1) : r * (q + 1) + (xcd - r) * q) + off; }
        const int nig = WGM * nN, gid = wgid / nig, fm = gid * WGM, gsz = (nM - fm) < WGM ? (nM - fm) : WGM;
        u.pm = fm + ((wgid % nig) % gsz); u.pn = (wgid % nig) / gsz; return true;
    }
};
template <class Epi>
__device__ __forceinline__ void gemm_phase(LAS unsigned char* lds, const Gemm g, const StaticOrder& S, const Epi& E) {
    int tid = threadIdx.x; asm volatile("" : "+v"(tid)); const int wid = __builtin_amdgcn_readfirstlane(tid >> 6), lane = tid & 63, wr = wid >> 2, wc = wid & 3, fr = lane & 15, fq = lane >> 4;
    const int K = g.K, nt = K / BK, lda = g.lda;
    unsigned voffA[2], voffB[2];
#pragma unroll
    for (int i = 0; i < 2; ++i) { int R, C; stage_rc(tid * 16 + i * 8192, R, C); voffA[i] = (unsigned)(R * lda + C) * 2u; voffB[i] = (unsigned)(R * K + C) * 2u; }
    const size_t kstep = (size_t)(BK * 2);
    const size_t hstepA = (size_t)HALF * lda * 2, tstepA = 2 * hstepA;
    const size_t hstepB = (size_t)HALF * K * 2, tstepB = 2 * hstepB;
    const unsigned ldsw = (unsigned)wid * 1024u;
    const int aoff = lds_byte(wr * 64 + fr, fq * 8), boff = lds_byte(wc * 32 + fr, fq * 8);
#define PG8_SA(b, h) (((b) * 2 + (h)) * HTB)
#define PG8_SB(b, h) ((4 + (b) * 2 + (h)) * HTB)
#define PG8_STAGE(bufoff, gbase, voff) do { _Pragma("unroll") for (int _i = 0; _i < 2; ++_i) \
        __builtin_amdgcn_global_load_lds((const unsigned*)((const char*)(gbase) + (voff)[_i]), (LAS unsigned*)(lds + (bufoff) + ldsw + _i * 8192), 16, 0, 0); } while (0)
#define PG8_LDA(dst, b, h) do { _Pragma("unroll") for (int m = 0; m < 4; ++m) _Pragma("unroll") for (int k = 0; k < 2; ++k) dst[m][k] = *(const LAS bf16x8*)(lds + PG8_SA(b, h) + aoff + m * 2048 + k * 1024); } while (0)
#define PG8_LDB(dst, b, h) do { _Pragma("unroll") for (int n = 0; n < 2; ++n) _Pragma("unroll") for (int k = 0; k < 2; ++k) dst[n][k] = *(const LAS bf16x8*)(lds + PG8_SB(b, h) + boff + n * 2048 + k * 1024); } while (0)
#define PG8_MMA(ai, bj, At, Bt) do { __builtin_amdgcn_s_setprio(1); _Pragma("unroll") for (int m = 0; m < 4; ++m) _Pragma("unroll") for (int n = 0; n < 2; ++n) _Pragma("unroll") for (int k = 0; k < 2; ++k) \
        acc[ai][bj][m][n] = __builtin_amdgcn_mfma_f32_16x16x32_bf16(Bt[n][k], At[m][k], acc[ai][bj][m][n], 0, 0, 0); __builtin_amdgcn_s_setprio(0); } while (0)
#define PG8_WAIT_V(n) asm volatile("s_waitcnt vmcnt(" #n ")" ::: "memory")
#define PG8_WAIT_L(n) asm volatile("s_waitcnt lgkmcnt(" #n ")" ::: "memory")
#define PG8_BAR __builtin_amdgcn_s_barrier()
#define PG8_SCHED __builtin_amdgcn_sched_barrier(0)
    Unit cur, nxt; int ui = 0;
    if (!S.next(0, cur)) return;
    if constexpr (Epi::NEED_RS) {
        LAS float* rst = (LAS float*)(lds + STAGE_BYTES); Unit uu;
        for (int i0 = 0; S.next(i0, uu); i0 += 2) { const int i = i0 + (tid >> 8); if (S.next(i, uu)) rst[i * 256 + (tid & 255)] = row_rs(E.ss, uu.pm * BM + (tid & 255)); }
    }
    f32x4 acc[2][2][4][2];
#pragma unroll
    for (int a = 0; a < 2; ++a)
#pragma unroll
        for (int b = 0; b < 2; ++b)
#pragma unroll
            for (int m = 0; m < 4; ++m)
#pragma unroll
                for (int n = 0; n < 2; ++n) acc[a][b][m][n] = (f32x4){0.f, 0.f, 0.f, 0.f};
    bf16x8 At[4][2], B0[2][2], B1[2][2];
    const char* cA = (const char*)g.A + (size_t)cur.pm * tstepA; const char* cB = (const char*)g.Bt + (size_t)cur.pn * tstepB;
    PG8_STAGE(PG8_SB(0, 0), cB, voffB); PG8_STAGE(PG8_SB(0, 1), cB + hstepB, voffB); PG8_STAGE(PG8_SA(0, 0), cA, voffA); PG8_STAGE(PG8_SA(0, 1), cA + hstepA, voffA);
    if (wr == 1) PG8_BAR;
    PG8_WAIT_V(2); PG8_BAR;
    PG8_STAGE(PG8_SB(1, 0), cB + kstep, voffB); PG8_STAGE(PG8_SA(1, 0), cA + kstep, voffA); PG8_STAGE(PG8_SB(1, 1), cB + hstepB + kstep, voffB);
    PG8_WAIT_V(6); PG8_BAR;
    for (;;) {
        const bool has_next = S.next(ui + 1, nxt);
        const char* nA = has_next ? (const char*)g.A + (size_t)nxt.pm * tstepA : cA; const char* nB = has_next ? (const char*)g.Bt + (size_t)nxt.pn * tstepB : cB;
        for (int t = 0; t < nt; t += 2) {
            const bool last = (t == nt - 2);
            const char* a1 = cA + (size_t)(t + 1) * kstep;
            const char* a2 = last ? nA : cA + (size_t)(t + 2) * kstep; const char* b2 = last ? nB : cB + (size_t)(t + 2) * kstep;
            const char* a3 = a2 + kstep; const char* b3 = b2 + kstep;
            PG8_LDB(B0, 0, 0); PG8_LDB(B1, 0, 1); PG8_SCHED; PG8_LDA(At, 0, 0); PG8_STAGE(PG8_SA(1, 1), a1 + hstepA, voffA);
            PG8_WAIT_V(8); PG8_WAIT_L(0); PG8_BAR; PG8_MMA(0, 0, At, B0); PG8_MMA(0, 1, At, B1); PG8_BAR; PG8_SCHED;
            PG8_LDA(At, 0, 1); PG8_STAGE(PG8_SB(0, 0), b2, voffB); PG8_STAGE(PG8_SB(0, 1), b2 + hstepB, voffB); PG8_STAGE(PG8_SA(0, 0), a2, voffA);
            PG8_WAIT_V(8); PG8_WAIT_L(0); PG8_BAR; PG8_MMA(1, 0, At, B0); PG8_MMA(1, 1, At, B1); PG8_BAR; PG8_SCHED;
            PG8_LDB(B0, 1, 0); PG8_LDB(B1, 1, 1); PG8_SCHED; PG8_LDA(At, 1, 0); PG8_STAGE(PG8_SA(0, 1), a2 + hstepA, voffA);
            PG8_WAIT_V(8); PG8_WAIT_L(0); PG8_BAR; PG8_MMA(0, 0, At, B0); PG8_MMA(0, 1, At, B1); PG8_BAR; PG8_SCHED;
            PG8_LDA(At, 1, 1); PG8_STAGE(PG8_SB(1, 0), b3, voffB); PG8_STAGE(PG8_SB(1, 1), b3 + hstepB, voffB); PG8_STAGE(PG8_SA(1, 0), a3, voffA);
            PG8_WAIT_V(8); PG8_WAIT_L(0); PG8_BAR; PG8_MMA(1, 0, At, B0); PG8_MMA(1, 1, At, B1); PG8_BAR; PG8_SCHED;
        }
        if (wr == 0) PG8_BAR;
        E(acc, cur, wr, wc, fr, fq, (const LAS float*)(lds + STAGE_BYTES) + ui * 256);
        if (!has_next) break;
#pragma unroll
        for (int a = 0; a < 2; ++a)
#pragma unroll
            for (int b = 0; b < 2; ++b)
#pragma unroll
                for (int m = 0; m < 4; ++m)
#pragma unroll
                    for (int n = 0; n < 2; ++n) acc[a][b][m][n] = (f32x4){0.f, 0.f, 0.f, 0.f};
        cur = nxt; cA = nA; cB = nB; ++ui;
        if (wr == 1) PG8_BAR;
    }
    PG8_WAIT_V(0);
    PG8_BAR;
#undef PG8_SA
#undef PG8_SB
#undef PG8_STAGE
#undef PG8_LDA
#undef PG8_LDB
#undef PG8_MMA
#undef PG8_WAIT_V
#undef PG8_WAIT_L
#undef PG8_BAR
#undef PG8_SCHED
}

struct EpiIn { static constexpr bool NEED_RS = true;
    bf16_t* P; const float* ss;
    __device__ __forceinline__ void operator()(const f32x4 (&acc)[2][2][4][2], const Unit& u, int wr, int wc, int fr, int fq, const LAS float* rsl) const {
        const int row0 = u.pm * BM + wr * 64 + fr, col0 = u.pn * BM + wc * 32 + 8 * fq; const bool act = u.pn >= 4;
#pragma unroll
        for (int ai = 0; ai < 2; ++ai)
#pragma unroll
            for (int m = 0; m < 4; ++m) { const int row = row0 + ai * HALF + m * 16; const float rs = rsl[ai * HALF + wr * 64 + m * 16 + fr];
                bf16_t* rowp = P + (size_t)row * NIN + col0;
#pragma unroll
                for (int bj = 0; bj < 2; ++bj) { f32x4 v0 = acc[ai][bj][m][0] * rs, v1 = acc[ai][bj][m][1] * rs;
                    if (act) { f32x4 t0 = v0 * (v0 * v0 * 0.044715f + 1.f), t1 = v1 * (v1 * v1 * 0.044715f + 1.f);
                        sigm8(t0, t1, -2.f * 0.7978845608f * 1.4426950409f); v0 = v0 * t0; v1 = v1 * t1; }
                    u32x4 w; w.x = cvt_pk_bf16(v0[0], v0[1]); w.y = cvt_pk_bf16(v0[2], v0[3]); w.z = cvt_pk_bf16(v1[0], v1[1]); w.w = cvt_pk_bf16(v1[2], v1[3]);
                    *(u32x4*)(rowp + bj * HALF) = w; } }
    }
};
struct EpiQKV { static constexpr bool NEED_RS = true;
    bf16_t* O; const float* ss; const float* rope; bf16_t* VT;
    __device__ __forceinline__ void operator()(const f32x4 (&acc)[2][2][4][2], const Unit& u, int wr, int wc, int fr, int fq, const LAS float* rsl) const {
        const int row0 = u.pm * BM + wr * 64 + fr;
        if (u.pn < 5) {
            const int dlo = 16 * (wc & 1) + 4 * fq;
#pragma unroll
            for (int ai = 0; ai < 2; ++ai) {
                f32x4 cs[4], sn[4];
#pragma unroll
                for (int m = 0; m < 4; ++m) { const int pos = (row0 + ai * HALF + m * 16) & (SEQ - 1); cs[m] = *(const f32x4*)(rope + (size_t)pos * 32 + dlo); sn[m] = *(const f32x4*)(rope + (size_t)SEQ * 32 + (size_t)pos * 32 + dlo); }
#pragma unroll
                for (int m = 0; m < 4; ++m) { const int row = row0 + ai * HALF + m * 16; const float rs = rsl[ai * HALF + wr * 64 + m * 16 + fr];
#pragma unroll
                    for (int bj = 0; bj < 2; ++bj) { const f32x4 x1 = acc[ai][bj][m][0] * rs, x2 = acc[ai][bj][m][1] * rs;
                        const f32x4 o1 = x1 * cs[m] - x2 * sn[m], o2 = x2 * cs[m] + x1 * sn[m];
                        bf16_t* dst = O + (size_t)row * NQKV + u.pn * BM + (2 * bj + (wc >> 1)) * 64 + dlo;
                        u32x2 w1, w2; w1.x = cvt_pk_bf16(o1[0], o1[1]); w1.y = cvt_pk_bf16(o1[2], o1[3]); w2.x = cvt_pk_bf16(o2[0], o2[1]); w2.y = cvt_pk_bf16(o2[2], o2[3]);
                        *(u32x2*)dst = w1; *(u32x2*)(dst + 32) = w2; } } }
        } else {
            const int c0 = wc * 32 + 8 * fq;
#pragma unroll
            for (int ai = 0; ai < 2; ++ai)
#pragma unroll
                for (int m = 0; m < 4; ++m) { const int row = row0 + ai * HALF + m * 16; const float rs = rsl[ai * HALF + wr * 64 + m * 16 + fr]; const int bidx = row >> 12, t = row & (SEQ - 1);
#pragma unroll
                    for (int bj = 0; bj < 2; ++bj) { const f32x4 v0 = acc[ai][bj][m][0] * rs, v1 = acc[ai][bj][m][1] * rs; const int c = c0 + bj * HALF;
                        bf16_t* dst = VT + ((size_t)bidx * 256 + c) * SEQ + t;
                        const unsigned w0 = cvt_pk_bf16(v0[0], v0[1]), w1 = cvt_pk_bf16(v0[2], v0[3]), w2 = cvt_pk_bf16(v1[0], v1[1]), w3 = cvt_pk_bf16(v1[2], v1[3]);
                        dst[0] = (bf16_t)(w0 & 0xffffu); dst[SEQ] = (bf16_t)(w0 >> 16); dst[2 * SEQ] = (bf16_t)(w1 & 0xffffu); dst[3 * SEQ] = (bf16_t)(w1 >> 16);
                        dst[4 * SEQ] = (bf16_t)(w2 & 0xffffu); dst[5 * SEQ] = (bf16_t)(w2 >> 16); dst[6 * SEQ] = (bf16_t)(w3 & 0xffffu); dst[7 * SEQ] = (bf16_t)(w3 >> 16); } }
        }
    }
};
struct EpiGU { static constexpr bool NEED_RS = true;
    bf16_t* O; const float* ss;
    __device__ __forceinline__ void operator()(const f32x4 (&acc)[2][2][4][2], const Unit& u, int wr, int wc, int fr, int fq, const LAS float* rsl) const {
        const int row0 = u.pm * BM + wr * 64 + fr, col0 = u.pn * HALF + wc * 32 + 8 * fq;
#pragma unroll
        for (int ai = 0; ai < 2; ++ai)
#pragma unroll
            for (int m = 0; m < 4; ++m) { const int row = row0 + ai * HALF + m * 16; const float rs = rsl[ai * HALF + wr * 64 + m * 16 + fr];
                const f32x4 g0 = acc[ai][0][m][0] * rs, g1 = acc[ai][0][m][1] * rs; f32x4 t0 = g0, t1 = g1;
                sigm8(t0, t1, -1.4426950409f);
                const f32x4 a0 = g0 * t0 * (acc[ai][1][m][0] * rs), a1 = g1 * t1 * (acc[ai][1][m][1] * rs);
                u32x4 w; w.x = cvt_pk_bf16(a0[0], a0[1]); w.y = cvt_pk_bf16(a0[2], a0[3]); w.z = cvt_pk_bf16(a1[0], a1[1]); w.w = cvt_pk_bf16(a1[2], a1[3]);
                *(u32x4*)(O + (size_t)row * DFF + col0) = w; }
    }
};
struct EpiRes { static constexpr bool NEED_RS = false;
    bf16_t* xb; float* ss;
    __device__ __forceinline__ void operator()(const f32x4 (&acc)[2][2][4][2], const Unit& u, int wr, int wc, int fr, int fq, const LAS float* rsl) const {
        const int row0 = u.pm * BM + wr * 64 + fr, col0 = u.pn * BM + wc * 32 + 8 * fq;
#pragma unroll
        for (int ai = 0; ai < 2; ++ai) {
            u32x4 bw[4][2];
#pragma unroll
            for (int m = 0; m < 4; ++m)
#pragma unroll
                for (int bj = 0; bj < 2; ++bj) bw[m][bj] = *(const u32x4*)(xb + (size_t)(row0 + ai * HALF + m * 16) * DM + col0 + bj * HALF);
#pragma unroll
            for (int m = 0; m < 4; ++m) { const int row = row0 + ai * HALF + m * 16; const size_t off = (size_t)row * DM + col0; float s = 0.f;
#pragma unroll
                for (int bj = 0; bj < 2; ++bj) { const size_t o = off + bj * HALF; const u32x4 b = bw[m][bj];
                    const f32x4 v0 = acc[ai][bj][m][0] + (f32x4){bflo(b.x), bfhi(b.x), bflo(b.y), bfhi(b.y)}, v1 = acc[ai][bj][m][1] + (f32x4){bflo(b.z), bfhi(b.z), bflo(b.w), bfhi(b.w)};
                    u32x4 w; w.x = cvt_pk_bf16(v0[0], v0[1]); w.y = cvt_pk_bf16(v0[2], v0[3]); w.z = cvt_pk_bf16(v1[0], v1[1]); w.w = cvt_pk_bf16(v1[2], v1[3]);
                    *(u32x4*)(xb + o) = w;
                    s += (v0[0] * v0[0] + v0[1] * v0[1]) + (v0[2] * v0[2] + v0[3] * v0[3]) + (v1[0] * v1[0] + v1[1] * v1[1]) + (v1[2] * v1[2] + v1[3] * v1[3]); }
                s += __shfl_xor(s, 16); s += __shfl_xor(s, 32);
                if (fq == 0) ss[(size_t)row * 16 + u.pn * 4 + wc] = s; } }
    }
};
}

struct Params {
    const float *x, *mix_norm, *ffn_norm, *final_norm, *even_w_in, *even_conv_w, *even_conv_b, *lru_w_r, *lru_b_r, *lru_w_i, *lru_b_i, *lru_lambda,
                *sg_ln_g, *sg_ln_b, *sg_w, *sg_b, *even_w_out, *attn_w_qkv, *attn_sinks, *attn_w_o, *ffn_w_gu, *ffn_w_down;
    float* out; unsigned char* ws; int ph_lo, ph_hi;
};

typedef const __attribute__((address_space(4))) Params* KP;
__device__ __forceinline__ int tid_opaque() { int t = threadIdx.x; asm volatile("" : "+v"(t)); return t; }
#define LDS_WAIT() asm volatile("s_waitcnt lgkmcnt(0)" ::: "memory")

__device__ __forceinline__ int phys32(int l) { return 16 * ((l >> 2) & 1) + 4 * (l >> 3) + (l & 3); }
__device__ __forceinline__ int map_col(int mode, int n) {
    if (mode == 0) return (n & ~31) | phys32(n & 31);
    if (mode == 1) { if (n >= 1280) return (n & ~31) | phys32(n & 31);
        const int tile = n >> 8, c = n & 255, head = c >> 6, d = c & 63, nn = d >> 5, r = d & 31, wcl = r >> 4, fq = (r >> 2) & 3, j = r & 3, bj = head >> 1, wc = 2 * (head & 1) + wcl;
        return tile * 256 + 128 * bj + 32 * wc + 16 * nn + 4 * fq + j; }
    if (mode == 2) { const int isu = n >= DFF ? 1 : 0, f = n - isu * DFF, pn = f >> 7, r = f & 127, wc = r >> 5, l = r & 31; return 256 * pn + 128 * isu + 32 * wc + phys32(l); }
    return n;
}
struct TrD { const float* W; const float* g; bf16_t* WT; int K, N, qcols, mode, r; float wscale; };
__device__ __forceinline__ void tr_load(const TrD& d, int lane, f32x4 (&v)[8]) {
    const int nblk = d.N / 32, kb = d.r / nblk, nb = d.r % nblk, k0 = 64 * kb, n0 = 32 * nb, nq = 4 * (lane & 7);
#pragma unroll
    for (int i = 0; i < 8; ++i) { const int kk = 8 * i + (lane >> 3); v[i] = *(const f32x4*)(d.W + (size_t)(k0 + kk) * d.N + n0 + nq); }
}
__device__ __forceinline__ void tr_finish(const TrD& d, int lane, const f32x4 (&v)[8], float* scr) {
    const int nblk = d.N / 32, kb = d.r / nblk, nb = d.r % nblk, k0 = 64 * kb, n0 = 32 * nb, nq = 4 * (lane & 7), K = d.K;
#pragma unroll
    for (int i = 0; i < 8; ++i) { const int kk = 8 * i + (lane >> 3); const float gs = d.g ? d.g[k0 + kk] : 1.0f; float* t = scr + kk * 33 + nq;
        t[0] = v[i][0] * gs; t[1] = v[i][1] * gs; t[2] = v[i][2] * gs; t[3] = v[i][3] * gs; }
    LDS_WAIT();
    const int c = lane & 7;
#pragma unroll
    for (int j = 0; j < 4; ++j) { const int n = (lane >> 3) + 8 * j; const float* s = scr + (8 * c) * 33 + n; const float sc = (n0 + n) < d.qcols ? 0.125f * 1.4426950409f : d.wscale;
        u32x4 o; o.x = cvt_pk_bf16(s[0 * 33] * sc, s[1 * 33] * sc); o.y = cvt_pk_bf16(s[2 * 33] * sc, s[3 * 33] * sc); o.z = cvt_pk_bf16(s[4 * 33] * sc, s[5 * 33] * sc); o.w = cvt_pk_bf16(s[6 * 33] * sc, s[7 * 33] * sc);
        *(u32x4*)(d.WT + (size_t)map_col(d.mode, n0 + n) * K + k0 + 8 * c) = o; }
    LDS_WAIT();
}
__device__ __forceinline__ void prologue(KP p, unsigned char* lds) {
    const int tid = tid_opaque(), lane = tid & 63, wave = tid >> 6, G = gridDim.x;
    const int gw = blockIdx.x * 8 + wave, NGW = G * 8;
    unsigned char* ws = p->ws;
    float* scr = (float*)(lds + wave * 8448);
    constexpr int I_IN = 16 * 128, I_OUT = 32 * 32, I_QKV = 16 * 48, I_O = 16 * 32, I_GU = 16 * 176, I_DN = 44 * 32, I_G = 2 * 4;
    constexpr int T0 = 2 * I_IN, T1 = T0 + 2 * I_OUT, T2 = T1 + 2 * I_QKV, T3 = T2 + 2 * I_O, T4 = T3 + 4 * I_GU, T5 = T4 + 4 * I_DN, T6 = T5 + 64 * I_G;
#define TR_DESC(D, IT) do { const int it_ = (IT); \
        if (it_ < T0) { const int j = it_ / I_IN; D = TrD{p->even_w_in + (size_t)j * DM * NIN, p->mix_norm + (2 * j) * DM, (bf16_t*)(ws + OFF_WIN) + (size_t)j * NIN * DM, DM, NIN, 0, 0, it_ % I_IN, 1.0f}; } \
        else if (it_ < T1) { const int q = it_ - T0, j = q / I_OUT; D = TrD{p->even_w_out + (size_t)j * KOUT * DM, nullptr, (bf16_t*)(ws + OFF_WOUT) + (size_t)j * DM * KOUT, KOUT, DM, 0, 0, q % I_OUT, 1.0f}; } \
        else if (it_ < T2) { const int q = it_ - T1, j = q / I_QKV; D = TrD{p->attn_w_qkv + (size_t)j * DM * NQKV, p->mix_norm + (2 * j + 1) * DM, (bf16_t*)(ws + OFF_WQKV) + (size_t)j * NQKV * DM, DM, NQKV, 1024, 1, q % I_QKV, 1.0f}; } \
        else if (it_ < T3) { const int q = it_ - T2, j = q / I_O; D = TrD{p->attn_w_o + (size_t)j * DM * DM, nullptr, (bf16_t*)(ws + OFF_WO) + (size_t)j * DM * DM, DM, DM, 0, 0, q % I_O, 1.0f}; } \
        else if (it_ < T4) { const int q = it_ - T3, l = q / I_GU; D = TrD{p->ffn_w_gu + (size_t)l * DM * NGU, p->ffn_norm + l * DM, (bf16_t*)(ws + OFF_WGU) + (size_t)l * NGU * DM, DM, NGU, 0, 2, q % I_GU, 1.0f}; } \
        else if (it_ < T5) { const int q = it_ - T4, l = q / I_DN; D = TrD{p->ffn_w_down + (size_t)l * DFF * DM, nullptr, (bf16_t*)(ws + OFF_WDN) + (size_t)l * DM * DFF, DFF, DM, 0, 0, q % I_DN, 1.0f}; } \
        else { const int q = it_ - T5, mi = q / I_G, ri = mi & 1, head = (mi >> 1) & 7, dir = (mi >> 4) & 1, j = mi >> 5;        \
            D = TrD{(ri ? p->lru_w_i : p->lru_w_r) + (size_t)((j * 2 + dir) * 8 + head) * 16384, nullptr, (bf16_t*)(ws + OFF_WG) + ((size_t)(j * 8 + head) * 512 + (dir * 2 + ri) * 128) * 128, 128, 128, 0, 3, q % I_G, -1.4426950409f}; } } while (0)
    for (int it = gw; it < T6; it += 2 * NGW) {
        TrD d0, d1; f32x4 v0[8], v1[8]; const bool two = it + NGW < T6;
        TR_DESC(d0, it); tr_load(d0, lane, v0);
        if (two) { TR_DESC(d1, it + NGW); tr_load(d1, lane, v1); }
        tr_finish(d0, lane, v0, scr);
        if (two) tr_finish(d1, lane, v1, scr);
    }
#undef TR_DESC
    const int gt = blockIdx.x * 512 + tid, NT = G * 512;
    { bf16_t* dst = (bf16_t*)(ws + OFF_WSG); for (int i = gt; i < 2 * 8 * 128 * 128 / 2; i += NT) { const f32x2 v = *(const f32x2*)(p->sg_w + 2 * (size_t)i); *(unsigned*)(dst + 2 * (size_t)i) = cvt_pk_bf16(v.x, v.y); } }
    { float* rc = (float*)(ws + OFF_ROPE); for (int i = gt; i < SEQ * 32; i += NT) { const int pos = i >> 5, f = i & 31;
        const float freq = __builtin_amdgcn_exp2f(-(float)f * (13.287712379549449f / 32.0f)); const float ang = (float)pos * freq;
        const double rev = (double)ang * 0.15915494309189535; const float fr = (float)(rev - __builtin_rint(rev));
        rc[i] = __builtin_amdgcn_cosf(fr); rc[SEQ * 32 + i] = __builtin_amdgcn_sinf(fr); } }
    { bf16_t* xb = (bf16_t*)(ws + OFF_XB); float* ss = (float*)(ws + OFF_SSP);
      for (int m0 = gw; m0 < MTOK; m0 += 4 * NGW) { f32x4 v[4][4];
#pragma unroll
        for (int r = 0; r < 4; ++r) { const int m = m0 + r * NGW; if (m < MTOK) { const f32x4* xr = (const f32x4*)(p->x + (size_t)m * DM) + lane;
#pragma unroll
            for (int j = 0; j < 4; ++j) v[r][j] = xr[64 * j]; } }
#pragma unroll
        for (int r = 0; r < 4; ++r) { const int m = m0 + r * NGW; if (m < MTOK) { float s = 0.f; u32x2* o8 = (u32x2*)(xb + (size_t)m * DM) + lane;
#pragma unroll
            for (int j = 0; j < 4; ++j) { const f32x4 q = v[r][j]; s += (q.x * q.x + q.y * q.y) + (q.z * q.z + q.w * q.w); u32x2 w; w.x = cvt_pk_bf16(q.x, q.y); w.y = cvt_pk_bf16(q.z, q.w); o8[64 * j] = w; }
            s = wave_sum(s); if (lane < 16) ss[(size_t)m * 16 + lane] = lane == 0 ? s : 0.f; } } } }
}

constexpr int LCH = 64, AUP = 132, XCP = 136;
__device__ __forceinline__ void lru_phase(KP p, int j, int pass, unsigned char* lds) {
    const int tid = tid_opaque(), lane = tid & 63, wave = tid >> 6, fr = lane & 15, fq = lane >> 4, G = gridDim.x;
    bf16_t* P = (bf16_t*)(p->ws + OFF_R1);
    float* agg = (float*)(p->ws + OFF_AGG);
    float* AF = (float*)lds; float* AB = AF + LCH * AUP;
    bf16_t* UF = (bf16_t*)(lds + 2 * LCH * AUP * 4); bf16_t* UB = UF + LCH * XCP;
    bf16_t* xcb = UB + LCH * XCP;
    bf16_t* xs = xcb + LCH * XCP;
    float* cbw = (float*)(xs + 68 * 128);
    const float* cw = p->even_conv_w + (size_t)j * 4 * DM; const float* cb = p->even_conv_b + (size_t)j * DM;
    const float NL2E = -1.4426950409f;
    for (int unit = blockIdx.x; unit < BATCH * 8 * 4; unit += G) {
      const int h = unit & 7, cq = (unit >> 3) & 3, b = unit >> 5, cfirst = cq * 16;
      const size_t abase = (size_t)b * 64 * 4 * DM + h * 128 + (tid & 127);
      float hcarry = 0.f;
      if (pass == 1 && tid < 256) {
          if (tid < 128) {
#pragma unroll 1
              for (int kb = 0; kb < cfirst; kb += 16) { float av[16], hv[16];
#pragma unroll
                  for (int i = 0; i < 16; ++i) { av[i] = agg[abase + (size_t)(((kb + i) * 2 + 0) * 2 + 0) * DM]; hv[i] = agg[abase + (size_t)(((kb + i) * 2 + 0) * 2 + 1) * DM]; }
#pragma unroll
                  for (int i = 0; i < 16; ++i) hcarry = av[i] * hcarry + hv[i]; }
          } else { float hc = 0.f;
#pragma unroll 1
              for (int kb = 63; kb >= cfirst; kb -= 16) { float av[16], hv[16]; const bool mine = (kb - 15 == cfirst);
#pragma unroll
                  for (int i = 0; i < 16; ++i) { av[i] = agg[abase + (size_t)(((kb - i) * 2 + 1) * 2 + 0) * DM]; hv[i] = agg[abase + (size_t)(((kb - i) * 2 + 1) * 2 + 1) * DM]; }
#pragma unroll
                  for (int i = 0; i < 16; ++i) { if (mine) cbw[(15 - i) * 128 + (tid & 127)] = hc; hc = av[i] * hc + hv[i]; } } }
      }
      const int ch2 = tid & 63, tg = (tid >> 6) & 3, cch = h * 128 + 2 * ch2; float w0[4], w1[4];
#pragma unroll
      for (int k = 0; k < 4; ++k) { w0[k] = cw[k * DM + cch]; w1[k] = cw[k * DM + cch + 1]; }
      const float cb0 = cb[cch], cb1 = cb[cch + 1];
      const int cs = 16 * wave, chl = cs + 4 * fq;
      float* gct = cbw + 16 * 128;
      if (tid < 128) { const int chg1 = h * 128 + tid;
          gct[0 * 128 + tid] = NL2E * p->lru_b_r[(size_t)(j * 2 + 0) * DM + chg1]; gct[1 * 128 + tid] = NL2E * p->lru_b_i[(size_t)(j * 2 + 0) * DM + chg1];
          gct[2 * 128 + tid] = NL2E * p->lru_b_r[(size_t)(j * 2 + 1) * DM + chg1]; gct[3 * 128 + tid] = NL2E * p->lru_b_i[(size_t)(j * 2 + 1) * DM + chg1];
          gct[4 * 128 + tid] = -8.f * 1.4426950409f * log1pf(__expf(-p->lru_lambda[(size_t)(j * 2 + 0) * DM + chg1])); gct[5 * 128 + tid] = -8.f * 1.4426950409f * log1pf(__expf(-p->lru_lambda[(size_t)(j * 2 + 1) * DM + chg1])); }
      const bf16_t* Wg = (const bf16_t*)(p->ws + OFF_WG) + (size_t)(j * 8 + h) * 512 * 128;
#define LRU_LOAD_PRE(T0) do { _Pragma("unroll") for (int i = 0; i < 3; ++i) { const int q = tid + 512 * i, rr = q >> 4, c8 = (q & 15) * 8, t = (T0) - 2 + rr; pre[i] = (u32x4){0u, 0u, 0u, 0u}; \
            if (q < 68 * 16 && t >= 0 && t < SEQ) pre[i] = *(const u32x4*)(P + ((size_t)b * SEQ + t) * NIN + h * 128 + c8); } } while (0)
#define LRU_STORE_PRE() do { _Pragma("unroll") for (int i = 0; i < 3; ++i) { const int q = tid + 512 * i, rr = q >> 4, c8 = (q & 15) * 8; if (q < 68 * 16) *(u32x4*)(xs + rr * 128 + c8) = pre[i]; } } while (0)
#define LRU_CONV() do { unsigned xr_[19]; _Pragma("unroll") for (int i = 0; i < 19; ++i) xr_[i] = *(const unsigned*)(xs + (tg * 16 + i) * 128 + 2 * ch2);     \
        _Pragma("unroll") for (int i = 0; i < 16; ++i) { const int t = tg * 16 + i; float y0 = cb0, y1 = cb1; \
            _Pragma("unroll") for (int k = 0; k < 4; ++k) { const unsigned w = xr_[i + k]; y0 += w0[k] * bflo(w); y1 += w1[k] * bfhi(w); } \
            *(unsigned*)(xcb + t * XCP + 2 * ch2) = cvt_pk_bf16(y0, y1); } } while (0)
      u32x4 pre[3];
      LRU_LOAD_PRE(cfirst * LCH);
      LRU_STORE_PRE();
      LRU_LOAD_PRE((cfirst + 1) * LCH);
      __syncthreads();
      if (wave >= 4) LRU_CONV();
      __syncthreads();
      for (int ci = 0; ci < 16; ++ci) {
        const int c = cfirst + ci, t0 = c * LCH; const size_t row0 = (size_t)b * SEQ + t0;
        if (ci < 15) LRU_STORE_PRE();
        { bf16x8 wd[2][4][2];
#pragma unroll
          for (int ks = 0; ks < 4; ++ks)
#pragma unroll
            for (int g = 0; g < 2; ++g) wd[0][ks][g] = *(const bf16x8*)(Wg + (size_t)(g * 128 + cs + fr) * 128 + 32 * ks + 8 * fq);
#pragma unroll
          for (int d = 0; d < 2; ++d) {
            f32x4 acc[2][4];
#pragma unroll
            for (int g = 0; g < 2; ++g)
#pragma unroll
              for (int m = 0; m < 4; ++m) acc[g][m] = (f32x4){0.f, 0.f, 0.f, 0.f};
            if (d == 0) {
#pragma unroll
              for (int ks = 0; ks < 4; ++ks)
#pragma unroll
                for (int g = 0; g < 2; ++g) wd[1][ks][g] = *(const bf16x8*)(Wg + (size_t)((2 + g) * 128 + cs + fr) * 128 + 32 * ks + 8 * fq); }
#pragma unroll
            for (int ks = 0; ks < 4; ++ks) { bf16x8 xf[4];
#pragma unroll
              for (int m = 0; m < 4; ++m) xf[m] = *(const bf16x8*)(xcb + (16 * m + fr) * XCP + 32 * ks + 8 * fq);
#pragma unroll
              for (int g = 0; g < 2; ++g)
#pragma unroll
                for (int m = 0; m < 4; ++m) acc[g][m] = __builtin_amdgcn_mfma_f32_16x16x32_bf16(wd[d][ks][g], xf[m], acc[g][m], 0, 0, 0); }
            const f32x4 br = *(const f32x4*)(gct + (2 * d) * 128 + chl), bi = *(const f32x4*)(gct + (2 * d + 1) * 128 + chl), ns = *(const f32x4*)(gct + (4 + d) * 128 + chl);
            float* Ad = d == 0 ? AF : AB; bf16_t* Ud = d == 0 ? UF : UB;
#pragma unroll
            for (int m = 0; m < 4; ++m) { const int tok = 16 * m + fr; const u32x2 xw = *(const u32x2*)(xcb + tok * XCP + chl);
                const f32x4 xv = (f32x4){bflo(xw.x), bfhi(xw.x), bflo(xw.y), bfhi(xw.y)}; f32x4 av, uv;
                { f32x4 e1 = acc[0][m] + br, e2 = acc[1][m] + bi;
#pragma unroll
                  for (int jj = 0; jj < 4; ++jj) { e1[jj] = __builtin_amdgcn_exp2f(fminf(e1[jj], 60.f)); e2[jj] = __builtin_amdgcn_exp2f(fminf(e2[jj], 60.f)); }
                  const f32x4 d1 = e1 + 1.f, d2 = e2 + 1.f; f32x4 tq = d1 * d2;
#pragma unroll
                  for (int jj = 0; jj < 4; ++jj) tq[jj] = __builtin_amdgcn_rcpf(tq[jj]);
                  const f32x4 la = (tq * d2) * ns, ig = tq * d1;
#pragma unroll
                  for (int jj = 0; jj < 4; ++jj) av[jj] = __builtin_amdgcn_exp2f(la[jj]);
                  f32x4 mq = 1.f - av * av;
#pragma unroll
                  for (int jj = 0; jj < 4; ++jj) mq[jj] = __builtin_amdgcn_sqrtf(fmaxf(mq[jj], 0.f));
                  uv = mq * ig * xv; }
                *(f32x4*)(Ad + tok * AUP + chl) = av;
                u32x2 pu; pu.x = cvt_pk_bf16(uv[0], uv[1]); pu.y = cvt_pk_bf16(uv[2], uv[3]);
                *(u32x2*)(Ud + tok * XCP + chl) = pu; } } }
        __syncthreads();
        if (ci < 14) LRU_LOAD_PRE(t0 + 2 * LCH);
        u32x4 gpre[2];
        if (pass == 1) {
#pragma unroll
            for (int i = 0; i < 2; ++i) { const int q = tid + 512 * i, t = q >> 4, c8 = (q & 15) * 8; gpre[i] = *(const u32x4*)(P + (row0 + t) * NIN + DM + h * 128 + c8); } }
        if (tid < 256) { const int ch = tid & 127, dir = tid >> 7; const float* A = (dir ? AB : AF) + ch; bf16_t* U = (dir ? UB : UF) + ch;
            float hcur = 0.f;
            if (pass == 1) hcur = dir == 0 ? hcarry : cbw[ci * 128 + ch];
            float ap = 1.f;
#define LRU_SCAN(T0, SGN) do { _Pragma("unroll") for (int tb = 0; tb < LCH; tb += 16) { float av[16], uv[16]; \
                const float* Ab = A + ((T0) + (SGN) * tb) * AUP; bf16_t* Ub = U + ((T0) + (SGN) * tb) * XCP; \
                _Pragma("unroll") for (int i = 0; i < 16; ++i) { av[i] = Ab[(SGN) * i * AUP]; uv[i] = bf2f(Ub[(SGN) * i * XCP]); } \
                _Pragma("unroll") for (int i = 0; i < 16; ++i) { hcur = av[i] * hcur + uv[i]; ap *= av[i]; uv[i] = hcur; } \
                if (pass == 1) { _Pragma("unroll") for (int i = 0; i < 16; ++i) Ub[(SGN) * i * XCP] = (bf16_t)(cvt_pk_bf16(uv[i], uv[i]) & 0xffffu); } } } while (0)
            if (dir == 0) LRU_SCAN(0, 1); else LRU_SCAN(LCH - 1, -1);
#undef LRU_SCAN
            if (pass == 0) { agg[abase + (size_t)((c * 2 + dir) * 2 + 0) * DM] = ap; agg[abase + (size_t)((c * 2 + dir) * 2 + 1) * DM] = hcur; }
            else if (dir == 0) hcarry = hcur;
        } else if (ci < 15) { LRU_CONV(); }
        __syncthreads();
        if (pass == 1) {
#pragma unroll
            for (int i = 0; i < 2; ++i) { const int q = tid + 512 * i, t = q >> 4, c8 = (q & 15) * 8; bf16_t* gp = P + (row0 + t) * NIN + DM + h * 128 + c8; const u32x4 gw = gpre[i];
                const u32x4 hf = *(const u32x4*)(UF + t * XCP + c8), hb = *(const u32x4*)(UB + t * XCP + c8);
                u32x4 w; w.x = cvt_pk_bf16(bflo(gw.x) * (bflo(hf.x) + bflo(hb.x)), bfhi(gw.x) * (bfhi(hf.x) + bfhi(hb.x))); w.y = cvt_pk_bf16(bflo(gw.y) * (bflo(hf.y) + bflo(hb.y)), bfhi(gw.y) * (bfhi(hf.y) + bfhi(hb.y)));
                w.z = cvt_pk_bf16(bflo(gw.z) * (bflo(hf.z) + bflo(hb.z)), bfhi(gw.z) * (bfhi(hf.z) + bfhi(hb.z))); w.w = cvt_pk_bf16(bflo(gw.w) * (bflo(hf.w) + bflo(hb.w)), bfhi(gw.w) * (bfhi(hf.w) + bfhi(hb.w)));
                *(u32x4*)gp = w; }
            __syncthreads();
        }
      }
#undef LRU_LOAD_PRE
#undef LRU_STORE_PRE
#undef LRU_CONV
    }
}

constexpr int VTP = 136;
typedef short v4i16_t __attribute__((ext_vector_type(4)));
__device__ __forceinline__ void sg_phase(KP p, int j, unsigned char* lds) {
    const int tid = tid_opaque(), lane = tid & 63, wave = tid >> 6, fr = lane & 15, fq = lane >> 4, G = gridDim.x;
    bf16_t* P = (bf16_t*)(p->ws + OFF_R1);
    bf16_t* vr = (bf16_t*)lds;
    float* mu = (float*)(lds + 128 * VTP * 2); float* rstd = mu + 128;
    const float* lng = p->sg_ln_g + (size_t)j * DM; const float* lnb = p->sg_ln_b + (size_t)j * DM;
    const int c8 = (tid & 15) * 8;
    for (int item = blockIdx.x; item < BATCH * 32; item += G) {
        const size_t row0 = (size_t)item * 128;
#pragma unroll
        for (int ip = 0; ip < 2; ++ip) { u32x4 w[2][8];
#pragma unroll
            for (int h2 = 0; h2 < 2; ++h2) { const int tok = wave * 16 + (2 * ip + h2) * 4 + fq; const bf16_t* zr = P + (row0 + tok) * NIN + 3072 + fr * 8;
#pragma unroll
                for (int k = 0; k < 8; ++k) w[h2][k] = *(const u32x4*)(zr + k * 128); }
#pragma unroll
            for (int h2 = 0; h2 < 2; ++h2) { const int tok = wave * 16 + (2 * ip + h2) * 4 + fq; float s = 0.f, s2 = 0.f;
#pragma unroll
                for (int k = 0; k < 8; ++k) { const u32x4 q = w[h2][k]; const float e[8] = {bflo(q.x), bfhi(q.x), bflo(q.y), bfhi(q.y), bflo(q.z), bfhi(q.z), bflo(q.w), bfhi(q.w)};
#pragma unroll
                    for (int z = 0; z < 8; ++z) { s += e[z]; s2 += e[z] * e[z]; } }
#pragma unroll
                for (int o = 1; o < 16; o <<= 1) { s += __shfl_xor(s, o); s2 += __shfl_xor(s2, o); }
                const float mean = s * (1.f / DM), var = fmaxf(s2 * (1.f / DM) - mean * mean, 0.f);
                if (fr == 0) { mu[tok] = mean; rstd[tok] = rsqrtf(var + EPS); } } }
        u32x4 tr[4];
#pragma unroll
        for (int i = 0; i < 4; ++i) tr[i] = *(const u32x4*)(P + (row0 + (tid >> 4) + 32 * i) * NIN + 3072 + c8);
        __syncthreads();
        for (int g = 0; g < 8; ++g) {
            { const f32x4 g0 = *(const f32x4*)(lng + g * 128 + c8), g1 = *(const f32x4*)(lng + g * 128 + c8 + 4), b0 = *(const f32x4*)(lnb + g * 128 + c8), b1 = *(const f32x4*)(lnb + g * 128 + c8 + 4);
#pragma unroll
              for (int i = 0; i < 4; ++i) { const int tok = (tid >> 4) + 32 * i; const float m = mu[tok], r = rstd[tok]; const u32x4 w = tr[i];
                  const f32x4 e0 = (f32x4){bflo(w.x), bfhi(w.x), bflo(w.y), bfhi(w.y)}, e1 = (f32x4){bflo(w.z), bfhi(w.z), bflo(w.w), bfhi(w.w)};
                  const f32x4 v0 = (e0 - m) * r * g0 + b0, v1 = (e1 - m) * r * g1 + b1;
                  u32x4 o; o.x = cvt_pk_bf16(v0[0], v0[1]); o.y = cvt_pk_bf16(v0[2], v0[3]); o.z = cvt_pk_bf16(v1[0], v1[1]); o.w = cvt_pk_bf16(v1[2], v1[3]);
                  *(u32x4*)(vr + tok * VTP + c8) = o; } }
            if (g < 7) {
#pragma unroll
                for (int i = 0; i < 4; ++i) tr[i] = *(const u32x4*)(P + (row0 + (tid >> 4) + 32 * i) * NIN + 3072 + (g + 1) * 128 + c8); }
            const int pt = 16 * wave + fr; bf16_t* ub = P + (row0 + pt) * NIN + 2048 + g * 128 + 4 * fq; u32x2 ur[8];
#pragma unroll
            for (int dt = 0; dt < 8; ++dt) ur[dt] = *(const u32x2*)(ub + 16 * dt);
            const bf16_t* Wsg = (const bf16_t*)(p->ws + OFF_WSG) + (size_t)(j * 8 + g) * 16384; bf16x8 wf[4];
#pragma unroll
            for (int ks = 0; ks < 4; ++ks) wf[ks] = *(const bf16x8*)(Wsg + (size_t)pt * 128 + 32 * ks + 8 * fq);
            const float sb = p->sg_b[(size_t)(j * 8 + g) * 128 + pt];
            __syncthreads();
            f32x4 acc[8];
#pragma unroll
            for (int dt = 0; dt < 8; ++dt) acc[dt] = (f32x4){0.f, 0.f, 0.f, 0.f};
            { v4i16_t lc[8], hc[8], ln[8], hn[8];
              { const bf16_t* vb = vr + (8 * fq + (fr >> 2)) * VTP + 4 * (fr & 3);
#pragma unroll
                for (int dt = 0; dt < 8; ++dt) { lc[dt] = __builtin_amdgcn_ds_read_tr16_b64_v4i16((LAS v4i16_t*)(vb + 16 * dt)); hc[dt] = __builtin_amdgcn_ds_read_tr16_b64_v4i16((LAS v4i16_t*)(vb + 4 * VTP + 16 * dt)); } }
              __builtin_amdgcn_sched_barrier(0);
#pragma unroll
              for (int ks = 0; ks < 4; ++ks) {
                  if (ks < 3) { const bf16_t* vb = vr + (32 * (ks + 1) + 8 * fq + (fr >> 2)) * VTP + 4 * (fr & 3);
#pragma unroll
                      for (int dt = 0; dt < 8; ++dt) { ln[dt] = __builtin_amdgcn_ds_read_tr16_b64_v4i16((LAS v4i16_t*)(vb + 16 * dt)); hn[dt] = __builtin_amdgcn_ds_read_tr16_b64_v4i16((LAS v4i16_t*)(vb + 4 * VTP + 16 * dt)); } }
                  __builtin_amdgcn_sched_barrier(0);
#pragma unroll
                  for (int dt = 0; dt < 8; ++dt) { const bf16x8 vf = (bf16x8){lc[dt][0], lc[dt][1], lc[dt][2], lc[dt][3], hc[dt][0], hc[dt][1], hc[dt][2], hc[dt][3]}; acc[dt] = __builtin_amdgcn_mfma_f32_16x16x32_bf16(vf, wf[ks], acc[dt], 0, 0, 0); }
                  __builtin_amdgcn_sched_barrier(0);
#pragma unroll
                  for (int dt = 0; dt < 8; ++dt) { lc[dt] = ln[dt]; hc[dt] = hn[dt]; } } }
#pragma unroll
            for (int dt = 0; dt < 8; ++dt) { const u32x2 uw = ur[dt];
                u32x2 o; o.x = cvt_pk_bf16(bflo(uw.x) * (acc[dt][0] + sb), bfhi(uw.x) * (acc[dt][1] + sb)); o.y = cvt_pk_bf16(bflo(uw.y) * (acc[dt][2] + sb), bfhi(uw.y) * (acc[dt][3] + sb));
                *(u32x2*)(ub + 16 * dt) = o; }
            __syncthreads();
        }
    }
}

constexpr int KLP = 72, VAP = 408, KROWS = 400;
__device__ __forceinline__ void attn_phase(KP p, int j, unsigned char* lds) {
    const int tid = tid_opaque(), lane = tid & 63, wave = tid >> 6, fr = lane & 15, fq = lane >> 4, G = gridDim.x;
    const bf16_t* QKV = (const bf16_t*)(p->ws + OFF_R1);
    bf16_t* AO = (bf16_t*)(p->ws + OFF_R1 + (size_t)MTOK * NQKV * 2);
    bf16_t* kl = (bf16_t*)lds;
    bf16_t* va = (bf16_t*)(lds + KROWS * KLP * 2);
    const float L2E = 1.4426950409f;
    for (int item = blockIdx.x; item < BATCH * 32 * 4; item += G) {
        const int kh = item & 3, qb = (item >> 2) & 31, b = item >> 7; const int qs = qb * 128, kpos0 = qs - 128; const size_t brow = (size_t)b * SEQ;
        { const bf16_t* VTb = (const bf16_t*)(p->ws + OFF_R1 + 160 * MiB) + ((size_t)b * 256 + kh * 64) * SEQ;
          u32x4 kreg[7], vreg[7];
#pragma unroll
          for (int it = 0; it < 7; ++it) { const int q = tid + 512 * it; kreg[it] = (u32x4){0u, 0u, 0u, 0u}; vreg[it] = kreg[it];
              if (q < KROWS * 8) { const int kk = q >> 3, d8 = (q & 7) * 8, kp = kpos0 + kk; if (kk < 384 && kp >= 0 && kp < SEQ) kreg[it] = *(const u32x4*)(QKV + (brow + kp) * NQKV + 1024 + kh * 64 + d8);
                  const int d = q / 50, k8 = (q - d * 50) * 8, vp = kpos0 + k8; if (k8 < 384 && vp >= 0 && vp < SEQ) vreg[it] = *(const u32x4*)(VTb + (size_t)d * SEQ + vp); } }
#pragma unroll
          for (int it = 0; it < 7; ++it) { const int q = tid + 512 * it;
              if (q < KROWS * 8) { const int kk = q >> 3, d8 = (q & 7) * 8; *(u32x4*)(kl + kk * KLP + d8) = kreg[it]; const int d = q / 50, k8 = (q - d * 50) * 8; *(u32x4*)(va + d * VAP + k8) = vreg[it]; } } }
        __syncthreads();
        const int hq = kh * 4 + (wave >> 1); const float sinkl = p->attn_sinks[j * 16 + hq] * L2E;
        const bool edge = (qb == 0) || (qb == 31);
        const bf16_t* qp0 = QKV + (brow + qs + (wave & 1) * 64 + fr) * NQKV + hq * 64 + 8 * fq;
        bf16x8 qn0 = *(const bf16x8*)qp0, qn1 = *(const bf16x8*)(qp0 + 32);
        for (int rt = 0; rt < 4; ++rt) {
            const int qi0 = (wave & 1) * 64 + 16 * rt, c0 = qi0 >> 4, qi = qi0 + fr;
            const bf16x8 qf0 = qn0, qf1 = qn1;
            if (rt < 3) { const bf16_t* qp = qp0 + (size_t)(16 * (rt + 1)) * NQKV; qn0 = *(const bf16x8*)qp; qn1 = *(const bf16x8*)(qp + 32); }
            f32x4 s[17];
            { bf16x8 kc[4][2], kn[4][2];
#pragma unroll
              for (int t = 0; t < 4; ++t) { const bf16_t* kp = kl + (16 * (c0 + t) + fr) * KLP + 8 * fq; kc[t][0] = *(const bf16x8*)kp; kc[t][1] = *(const bf16x8*)(kp + 32); }
              __builtin_amdgcn_sched_barrier(0);
#pragma unroll
              for (int g = 0; g < 5; ++g) {
#pragma unroll
                  for (int t = 0; t < 4; ++t) if (4 * (g + 1) + t < 17) { const bf16_t* kp = kl + (16 * (c0 + 4 * (g + 1) + t) + fr) * KLP + 8 * fq; kn[t][0] = *(const bf16x8*)kp; kn[t][1] = *(const bf16x8*)(kp + 32); }
                  __builtin_amdgcn_sched_barrier(0);
                  f32x4 h[4];
#pragma unroll
                  for (int t = 0; t < 4; ++t) if (4 * g + t < 17) h[t] = __builtin_amdgcn_mfma_f32_16x16x32_bf16(kc[t][0], qf0, (f32x4){0.f, 0.f, 0.f, 0.f}, 0, 0, 0);
#pragma unroll
                  for (int t = 0; t < 4; ++t) if (4 * g + t < 17) s[4 * g + t] = __builtin_amdgcn_mfma_f32_16x16x32_bf16(kc[t][1], qf1, h[t], 0, 0, 0);
                  __builtin_amdgcn_sched_barrier(0);
#pragma unroll
                  for (int t = 0; t < 4; ++t) { kc[t][0] = kn[t][0]; kc[t][1] = kn[t][1]; } } }
            if (edge) {
#pragma unroll
                for (int i = 0; i < 17; ++i)
#pragma unroll
                    for (int jj = 0; jj < 4; ++jj) { const int kk = 16 * (c0 + i) + 4 * fq + jj; const bool ok = (kk >= qi) && (kk <= qi + 256) && (kpos0 + kk >= 0) && (kpos0 + kk < SEQ); s[i][jj] = ok ? s[i][jj] : -1e30f; }
            } else {
#pragma unroll
                for (int jj = 0; jj < 4; ++jj) { s[0][jj] = (4 * fq + jj >= fr) ? s[0][jj] : -1e30f; s[16][jj] = (4 * fq + jj <= fr) ? s[16][jj] : -1e30f; }
            }
            float mx = -1e30f;
#pragma unroll
            for (int i = 0; i < 17; ++i) mx = fmaxf(fmaxf(mx, fmaxf(s[i][0], s[i][1])), fmaxf(s[i][2], s[i][3]));
            mx = fmaxf(mx, __shfl_xor(mx, 16)); mx = fmaxf(mx, __shfl_xor(mx, 32)); mx = fmaxf(mx, sinkl);
            float sum = 0.f;
#pragma unroll
            for (int i = 0; i < 17; ++i)
#pragma unroll
                for (int jj = 0; jj < 4; ++jj) { const float e = __builtin_amdgcn_exp2f(s[i][jj] - mx); s[i][jj] = e; sum += e; }
            sum += __shfl_xor(sum, 16); sum += __shfl_xor(sum, 32); sum += __builtin_amdgcn_exp2f(sinkl - mx);
            const float inv = 1.f / sum;
            f32x4 o[4];
#pragma unroll
            for (int dt = 0; dt < 4; ++dt) o[dt] = (f32x4){0.f, 0.f, 0.f, 0.f};
            { bf16x8 vc[4], vn[4];
#pragma unroll
              for (int dt = 0; dt < 4; ++dt) { const bf16_t* vp = va + (16 * dt + fr) * VAP + 16 * c0 + 4 * fq; const u32x2 lo = *(const u32x2*)vp, hi = *(const u32x2*)(vp + 16); vc[dt] = __builtin_bit_cast(bf16x8, (u32x4){lo.x, lo.y, hi.x, hi.y}); }
              __builtin_amdgcn_sched_barrier(0);
#pragma unroll
              for (int k2 = 0; k2 < 9; ++k2) {
                  if (k2 < 8) {
#pragma unroll
                      for (int dt = 0; dt < 4; ++dt) { const bf16_t* vp = va + (16 * dt + fr) * VAP + 16 * (c0 + 2 * (k2 + 1)) + 4 * fq; const u32x2 lo = *(const u32x2*)vp, hi = *(const u32x2*)(vp + 16); vn[dt] = __builtin_bit_cast(bf16x8, (u32x4){lo.x, lo.y, hi.x, hi.y}); } }
                  u32x4 pw; pw.x = cvt_pk_bf16(s[2 * k2][0], s[2 * k2][1]); pw.y = cvt_pk_bf16(s[2 * k2][2], s[2 * k2][3]);
                  if (k2 < 8) { pw.z = cvt_pk_bf16(s[(2 * k2 + 1) & 15][0], s[(2 * k2 + 1) & 15][1]); pw.w = cvt_pk_bf16(s[(2 * k2 + 1) & 15][2], s[(2 * k2 + 1) & 15][3]); } else { pw.z = 0u; pw.w = 0u; }
                  const bf16x8 pf = __builtin_bit_cast(bf16x8, pw);
                  __builtin_amdgcn_sched_barrier(0);
#pragma unroll
                  for (int dt = 0; dt < 4; ++dt) o[dt] = __builtin_amdgcn_mfma_f32_16x16x32_bf16(vc[dt], pf, o[dt], 0, 0, 0);
                  __builtin_amdgcn_sched_barrier(0);
#pragma unroll
                  for (int dt = 0; dt < 4; ++dt) vc[dt] = vn[dt]; } }
            bf16_t* op = AO + (brow + qs + qi) * DM + hq * 64 + 4 * fq;
#pragma unroll
            for (int dt = 0; dt < 4; ++dt) { u32x2 w; w.x = cvt_pk_bf16(o[dt][0] * inv, o[dt][1] * inv); w.y = cvt_pk_bf16(o[dt][2] * inv, o[dt][3] * inv); *(u32x2*)(op + 16 * dt) = w; }
        }
        __syncthreads();
    }
}

__device__ __forceinline__ void final_phase(KP p) {
    const int tid = tid_opaque(), lane = tid & 63, wave = tid >> 6, G = gridDim.x; const int gw = blockIdx.x * 8 + wave, NGW = G * 8;
    const float* ss = (const float*)(p->ws + OFF_SSP) + (size_t)8 * MTOK * 16; const bf16_t* xb = (const bf16_t*)(p->ws + OFF_XB);
    for (int m0 = gw; m0 < MTOK; m0 += 4 * NGW) { u32x2 w[4][4]; float rs[4];
#pragma unroll
        for (int r = 0; r < 4; ++r) { const int m = m0 + r * NGW; if (m < MTOK) { rs[r] = row_rs(ss, m); const u32x2* xr = (const u32x2*)(xb + (size_t)m * DM) + lane;
#pragma unroll
            for (int jj = 0; jj < 4; ++jj) w[r][jj] = xr[64 * jj]; } }
#pragma unroll
        for (int r = 0; r < 4; ++r) { const int m = m0 + r * NGW; if (m < MTOK) { f32x4* orow = (f32x4*)(p->out + (size_t)m * DM) + lane; const f32x4* gr = (const f32x4*)p->final_norm + lane;
#pragma unroll
            for (int jj = 0; jj < 4; ++jj) { const f32x4 v = (f32x4){bflo(w[r][jj].x), bfhi(w[r][jj].x), bflo(w[r][jj].y), bfhi(w[r][jj].y)}, g = gr[64 * jj]; orow[64 * jj] = v * rs[r] * g; } } } }
}

#define XB_TMO      128
#define XB_XCNT(j)  (256  + 64 * (j))
#define XB_XSUB(j)  (1280 + 64 * (j))
#define XB_XGEN(j)  (2304 + 64 * (j))
#define XB_TOP      3328
#define XB_TOPGEN   3392
#define XCD_BAR_WORDS 3456
#define XB_SPIN_CAP (1u << 22)
__device__ __forceinline__ unsigned xb_ld(unsigned* p)              { return __hip_atomic_load(p, __ATOMIC_RELAXED, __HIP_MEMORY_SCOPE_AGENT); }
__device__ __forceinline__ unsigned xb_add(unsigned* p, unsigned v) { return __hip_atomic_fetch_add(p, v, __ATOMIC_RELAXED, __HIP_MEMORY_SCOPE_AGENT); }
__device__ __forceinline__ unsigned xb_xcc_id() { return (unsigned)__builtin_amdgcn_s_getreg((3 << 11) | 20) & 0xFu; }
#define XB_SPIN(cond, bar) do { unsigned _sp = 0; while (cond) { __builtin_amdgcn_s_sleep(1); \
    if ((++_sp & 255u) == 0u) { if (xb_ld(&(bar)[XB_TMO])) break; if (_sp > XB_SPIN_CAP) { atomicAdd(&(bar)[XB_TMO], 1u); break; } } } } while (0)
__device__ __forceinline__ void xcd_barrier_complete(unsigned* bar, unsigned x, unsigned& nloc, unsigned& nx) {
    const unsigned G = gridDim.x * gridDim.y * gridDim.z;
    unsigned sum, cnt, mine, sp = 0u;
    for (;;) {
        sum = 0u; cnt = 0u; mine = 0u;
#pragma unroll
        for (unsigned j = 0; j < 16; ++j) { const unsigned c = xb_ld(&bar[XB_XCNT(j)]); sum += c; cnt += (c > 0u) ? 1u : 0u; mine = (j == x) ? c : mine; }
        if (sum == G) break;
        __builtin_amdgcn_s_sleep(1);
        if ((++sp & 255u) == 0u) { if (xb_ld(&bar[XB_TMO])) break; if (sp > XB_SPIN_CAP) { atomicAdd(&bar[XB_TMO], 1u); break; } }
    }
    nloc = mine > 0u ? mine : 1u; nx = cnt > 0u ? cnt : 1u;
}
__device__ __forceinline__ void xcd_barrier(unsigned* bar, volatile LAS unsigned* st) {
    asm volatile("s_waitcnt vmcnt(0)" ::: "memory");
    __syncthreads();
    if (threadIdx.x == 0) {
        const unsigned x = xb_xcc_id();
        __builtin_amdgcn_s_waitcnt(0);
        unsigned nloc = st[0], nx = st[1];
        if (nloc == 0u) { xcd_barrier_complete(bar, x, nloc, nx); st[0] = nloc; st[1] = nx; }
        const unsigned old = xb_add(&bar[XB_XSUB(x)], 1u);
        const unsigned gen = old / nloc;
        if (old + 1u == (gen + 1u) * nloc) {
            __builtin_amdgcn_fence(__ATOMIC_RELEASE, "agent");
            asm volatile("s_waitcnt vmcnt(0)" ::: "memory");
            const unsigned og = xb_add(&bar[XB_TOP], 1u);
            const unsigned tg = og / nx;
            if (og + 1u == (tg + 1u) * nx) xb_add(&bar[XB_TOPGEN], 1u);
            else XB_SPIN(xb_ld(&bar[XB_TOPGEN]) == tg, bar);
            __builtin_amdgcn_fence(__ATOMIC_ACQUIRE, "agent");
            xb_add(&bar[XB_XGEN(x)], 1u);
            asm volatile("s_waitcnt vmcnt(0)" ::: "memory");
        } else {
            XB_SPIN(xb_ld(&bar[XB_XGEN(x)]) == gen, bar);
            __builtin_amdgcn_fence(__ATOMIC_ACQUIRE, "agent");
            asm volatile("s_waitcnt vmcnt(0)" ::: "memory");
        }
    }
    __syncthreads();
}

__device__ __forceinline__ void run_phase(KP p, int ph, unsigned char* lds) {
    if (ph == 0) { prologue(p, lds); return; }
    if (ph == NPHASE - 1) { final_phase(p); return; }
    const int q = ph - 1; int layer, sub;
    if (q < 6) { layer = 0; sub = q; } else if (q < 11) { layer = 1; sub = q - 6; } else if (q < 17) { layer = 2; sub = q - 11; } else { layer = 3; sub = q - 17; }
    const int j = layer >> 1; const bool even = (layer & 1) == 0; const int nmix = even ? 4 : 3;
    unsigned char* ws = p->ws; float* ss = (float*)(ws + OFF_SSP); bf16_t* xb = (bf16_t*)(ws + OFF_XB); bf16_t* R1 = (bf16_t*)(ws + OFF_R1);
    LAS unsigned char* l3 = (LAS unsigned char*)lds;
    pg8::StaticOrder S;
    if (sub < nmix - 1) {
        if (even) {
            if (sub == 0) { pg8::Gemm g{xb, (const bf16_t*)(ws + OFF_WIN) + (size_t)j * NIN * DM, MTOK, NIN, DM, DM}; S.init(MTOK, NIN, gridDim.x, blockIdx.x);
                pg8::EpiIn E{R1, ss + (size_t)(2 * layer) * MTOK * 16}; pg8::gemm_phase<pg8::EpiIn>(l3, g, S, E); }
            else if (sub == 1) { lru_phase(p, j, 0, lds); sg_phase(p, j, lds); }
            else { lru_phase(p, j, 1, lds); }
        } else {
            if (sub == 0) { pg8::Gemm g{xb, (const bf16_t*)(ws + OFF_WQKV) + (size_t)j * NQKV * DM, MTOK, NQKV, DM, DM}; S.init(MTOK, NQKV, gridDim.x, blockIdx.x);
                pg8::EpiQKV E{R1, ss + (size_t)(2 * layer) * MTOK * 16, (const float*)(ws + OFF_ROPE), (bf16_t*)(ws + OFF_R1 + 160 * MiB)}; pg8::gemm_phase<pg8::EpiQKV>(l3, g, S, E); }
            else { attn_phase(p, j, lds); }
        }
        return;
    }
    if (sub == nmix) {
        pg8::Gemm g{xb, (const bf16_t*)(ws + OFF_WGU) + (size_t)layer * NGU * DM, MTOK, NGU, DM, DM}; S.init(MTOK, NGU, gridDim.x, blockIdx.x);
        pg8::EpiGU E{R1, ss + (size_t)(2 * layer + 1) * MTOK * 16}; pg8::gemm_phase<pg8::EpiGU>(l3, g, S, E);
        return;
    }
    pg8::Gemm g; float* ssn;
    if (sub == nmix - 1) {
        if (even) g = pg8::Gemm{R1 + DM, (const bf16_t*)(ws + OFF_WOUT) + (size_t)j * DM * KOUT, MTOK, DM, KOUT, NIN};
        else g = pg8::Gemm{R1 + (size_t)MTOK * NQKV, (const bf16_t*)(ws + OFF_WO) + (size_t)j * DM * DM, MTOK, DM, DM, DM};
        ssn = ss + (size_t)(2 * layer + 1) * MTOK * 16;
    } else {
        g = pg8::Gemm{R1, (const bf16_t*)(ws + OFF_WDN) + (size_t)layer * DM * DFF, MTOK, DM, DFF, DFF};
        ssn = ss + (size_t)(2 * layer + 2) * MTOK * 16;
    }
    S.init(MTOK, DM, gridDim.x, blockIdx.x);
    pg8::EpiRes E{xb, ssn}; pg8::gemm_phase<pg8::EpiRes>(l3, g, S, E);
}

__global__ void __launch_bounds__(512, 2) mega(Params pv) {
    extern __shared__ __attribute__((aligned(16))) unsigned char lds[];
    cg::grid_group grid = cg::this_grid();
    volatile LAS unsigned* st = (volatile LAS unsigned*)((LAS unsigned char*)lds + MISC_OFF);
    if (threadIdx.x < 2) st[threadIdx.x] = 0u;
    if (threadIdx.x == 0) (void)xb_add((unsigned*)(pv.ws + OFF_BAR) + XB_XCNT(xb_xcc_id()), 1u);
    __syncthreads();
    for (int ph = pv.ph_lo; ph < pv.ph_hi; ++ph) {
        KP p = (KP)__builtin_amdgcn_kernarg_segment_ptr(); asm volatile("" : "+s"(p));
        run_phase(p, ph, lds);
        if (ph + 1 < pv.ph_hi) { if (pv.ph_lo < 0) grid.sync(); else xcd_barrier((unsigned*)(p->ws + OFF_BAR), st); }
    }
}

extern "C" void kernel_launch(void* const* d_in, const int* in_sizes, int n_in, void* d_out, int out_size, void* d_ws, size_t ws_size, hipStream_t stream) {
    static int grid = 0;
    if (grid == 0) {
        if (n_in != 22 || ws_size < WS_NEED) { fprintf(stderr, "kernel_launch: unexpected n_in %d or ws_size %zu (< %zu)\n", n_in, ws_size, (size_t)WS_NEED); grid = -1; return; }
        int dev = 0, cus = 0, per_cu = 0;
        hipGetDevice(&dev); hipDeviceGetAttribute(&cus, hipDeviceAttributeMultiprocessorCount, dev);
        if (hipFuncSetAttribute((const void*)mega, hipFuncAttributeMaxDynamicSharedMemorySize, LDS_BYTES) != hipSuccess) { fprintf(stderr, "kernel_launch: hipFuncSetAttribute failed\n"); grid = -1; return; }
        if (hipOccupancyMaxActiveBlocksPerMultiprocessor(&per_cu, (const void*)mega, 512, LDS_BYTES) != hipSuccess || per_cu < 1) { fprintf(stderr, "kernel_launch: occupancy query gave %d\n", per_cu); per_cu = 1; }
        (void)hipGetLastError();
        grid = cus * 1;
    }
    if (grid < 0) return;
    if (hipMemsetAsync((char*)d_ws + OFF_BAR, 0, 16384, stream) != hipSuccess) { fprintf(stderr, "kernel_launch: memset failed\n"); return; }
    Params p{};
    const float** f = (const float**)&p;
    for (int i = 0; i < 22; ++i) f[i] = (const float*)d_in[i];
    p.out = (float*)d_out; p.ws = (unsigned char*)d_ws;
    p.ph_lo = 0; p.ph_hi = NPHASE;
    void* args[] = {&p};
    hipError_t e = hipLaunchCooperativeKernel((const void*)mega, dim3(grid), dim3(512), args, LDS_BYTES, stream);
    if (e != hipSuccess) fprintf(stderr, "cooperative launch failed: %s (grid %d)\n", hipGetErrorString(e), grid);
}
```

```cpp
#include <hip/hip_runtime.h>
#include <hip/hip_cooperative_groups.h>
#include <cstdio>
#include <cstdint>
namespace cg = cooperative_groups;


#define LAS __attribute__((address_space(3)))
typedef unsigned short bf16_t;
typedef short bf16x8 __attribute__((ext_vector_type(8)));
typedef float f32x4 __attribute__((ext_vector_type(4)));
typedef float f32x2 __attribute__((ext_vector_type(2)));
typedef unsigned u32x4 __attribute__((ext_vector_type(4)));
typedef unsigned u32x2 __attribute__((ext_vector_type(2)));

constexpr int BATCH = 8, SEQ = 4096, DM = 1024, MTOK = BATCH * SEQ;
constexpr int NIN = 4096, NQKV = 1536, DFF = 2816, NGU = 5632, KOUT = 2048;
constexpr float EPS = 1e-6f;
constexpr int NPHASE = 24;

constexpr size_t MiB = 1u << 20;
constexpr size_t OFF_WIN = 0, OFF_WOUT = 16 * MiB, OFF_WQKV = 24 * MiB, OFF_WO = 30 * MiB, OFF_WGU = 34 * MiB, OFF_WDN = 78 * MiB;
constexpr size_t OFF_WG = 100 * MiB, OFF_WSG = 102 * MiB, OFF_ROPE = 103 * MiB, OFF_SS = 104 * MiB, OFF_AGG = 106 * MiB, OFF_XB = 114 * MiB, OFF_R1 = 178 * MiB;
constexpr size_t OFF_SSP = 434 * MiB;
constexpr size_t WS_NEED = 454 * MiB;
constexpr int MISC_OFF = 152576 + 8192;
constexpr int LDS_BYTES = MISC_OFF + 16;
constexpr size_t OFF_BAR = 104 * MiB;

__device__ __forceinline__ unsigned cvt_pk_bf16(float lo, float hi) { unsigned r; asm("v_cvt_pk_bf16_f32 %0, %1, %2" : "=v"(r) : "v"(lo), "v"(hi)); return r; }
__device__ __forceinline__ float bf2f(unsigned short b) { return __uint_as_float(((unsigned)b) << 16); }
__device__ __forceinline__ float bflo(unsigned w) { return __uint_as_float(w << 16); }
__device__ __forceinline__ float bfhi(unsigned w) { return __uint_as_float(w & 0xffff0000u); }
__device__ __forceinline__ float gelu_t(float x) { const float t = x * (1.f + 0.044715f * x * x) * (-2.f * 0.7978845608f * 1.4426950409f); return x * __builtin_amdgcn_rcpf(1.f + __builtin_amdgcn_exp2f(t)); }
__device__ __forceinline__ float sigm(float x) { return __builtin_amdgcn_rcpf(1.f + __builtin_amdgcn_exp2f(-1.4426950409f * x)); }
__device__ __forceinline__ float silu_f(float x) { return x * sigm(x); }
__device__ __forceinline__ void sigm8(f32x4& a, f32x4& b, float scale) {
    a = a * scale; b = b * scale;
#pragma unroll
    for (int j = 0; j < 4; ++j) { a[j] = __builtin_amdgcn_exp2f(a[j]); b[j] = __builtin_amdgcn_exp2f(b[j]); }
    a = a + 1.f; b = b + 1.f;
#pragma unroll
    for (int j = 0; j < 4; ++j) { a[j] = __builtin_amdgcn_rcpf(a[j]); b[j] = __builtin_amdgcn_rcpf(b[j]); }
}
__device__ __forceinline__ float wave_sum(float v) {
#pragma unroll
    for (int o = 1; o < 64; o <<= 1) v += __shfl_xor(v, o);
    return v;
}

__device__ __forceinline__ float row_rs(const float* ssp, int row) {
    const f32x4* q = (const f32x4*)(ssp + (size_t)row * 16); const f32x4 a = q[0], b = q[1], c = q[2], d = q[3];
    const float s = ((a[0] + a[1]) + (a[2] + a[3])) + ((b[0] + b[1]) + (b[2] + b[3])) + (((c[0] + c[1]) + (c[2] + c[3])) + ((d[0] + d[1]) + (d[2] + d[3])));
    return rsqrtf(s * (1.f / DM) + EPS);
}

namespace pg8 {
constexpr int BM = 256, BK = 64, HALF = 128, HTB = HALF * BK * 2, STAGE_BYTES = 8 * HTB, NXCD = 8, WGM = 8;
__host__ __device__ __forceinline__ int lds_byte(int r, int c) { const int st = (r >> 4) * 2 + (c >> 5), rr = r & 15, cc = c & 31, ob = rr * 64 + cc * 2; return st * 1024 + (ob ^ (((ob >> 9) & 1) << 5)); }
__host__ __device__ __forceinline__ void stage_rc(int b, int& R, int& C) { const int st = b / 1024, sb = b % 1024, swz = sb ^ (((sb >> 9) & 1) << 5); R = (st >> 1) * 16 + swz / 64; C = (st & 1) * 32 + (swz % 64) / 2; }
struct Unit { int pm, pn; };
struct Gemm { const bf16_t* A; const bf16_t* Bt; int M, N, K, lda; };
struct StaticOrder {
    int nM, nN, nwg, G, c;
    __device__ void init(int M, int N, int G_, int c_) { nM = M / BM; nN = N / BM; nwg = nM * nN; G = G_; c = c_; }
    __device__ bool next(int i, Unit& u) const {
        const long L = (long)i * G + c; if (L >= nwg) return false;
        int wgid = (int)L; { const int q = nwg / NXCD, r = nwg % NXCD, xcd = wgid % NXCD, off = wgid / NXCD; wgid = (xcd < r ? xcd * (q + 1) : r * (q + 1) + (xcd - r) * q) + off; }
        const int nig = WGM * nN, gid = wgid / nig, fm = gid * WGM, gsz = (nM - fm) < WGM ? (nM - fm) : WGM;
        u.pm = fm + ((wgid % nig) % gsz); u.pn = (wgid % nig) / gsz; return true;
    }
};
template <class Epi>
__device__ __forceinline__ void gemm_phase(LAS unsigned char* lds, const Gemm g, const StaticOrder& S, const Epi& E) {
    int tid = threadIdx.x; asm volatile("" : "+v"(tid)); const int wid = __builtin_amdgcn_readfirstlane(tid >> 6), lane = tid & 63, wr = wid >> 2, wc = wid & 3, fr = lane & 15, fq = lane >> 4;
    const int K = g.K, nt = K / BK, lda = g.lda;
    unsigned voffA[2], voffB[2];
#pragma unroll
    for (int i = 0; i < 2; ++i) { int R, C; stage_rc(tid * 16 + i * 8192, R, C); voffA[i] = (unsigned)(R * lda + C) * 2u; voffB[i] = (unsigned)(R * K + C) * 2u; }
    const size_t kstep = (size_t)(BK * 2);
    const size_t hstepA = (size_t)HALF * lda * 2, tstepA = 2 * hstepA;
    const size_t hstepB = (size_t)HALF * K * 2, tstepB = 2 * hstepB;
    const unsigned ldsw = (unsigned)wid * 1024u;
    const int aoff = lds_byte(wr * 64 + fr, fq * 8), boff = lds_byte(wc * 32 + fr, fq * 8);
#define PG8_SA(b, h) (((b) * 2 + (h)) * HTB)
#define PG8_SB(b, h) ((4 + (b) * 2 + (h)) * HTB)
#define PG8_STAGE(bufoff, gbase, voff) do { _Pragma("unroll") for (int _i = 0; _i < 2; ++_i) \
        __builtin_amdgcn_global_load_lds((const unsigned*)((const char*)(gbase) + (voff)[_i]), (LAS unsigned*)(lds + (bufoff) + ldsw + _i * 8192), 16, 0, 0); } while (0)
#define PG8_LDA(dst, b, h) do { _Pragma("unroll") for (int m = 0; m < 4; ++m) _Pragma("unroll") for (int k = 0; k < 2; ++k) dst[m][k] = *(const LAS bf16x8*)(lds + PG8_SA(b, h) + aoff + m * 2048 + k * 1024); } while (0)
#define PG8_LDB(dst, b, h) do { _Pragma("unroll") for (int n = 0; n < 2; ++n) _Pragma("unroll") for (int k = 0; k < 2; ++k) dst[n][k] = *(const LAS bf16x8*)(lds + PG8_SB(b, h) + boff + n * 2048 + k * 1024); } while (0)
#define PG8_MMA(ai, bj, At, Bt) do { __builtin_amdgcn_s_setprio(1); _Pragma("unroll") for (int m = 0; m < 4; ++m) _Pragma("unroll") for (int n = 0; n < 2; ++n) _Pragma("unroll") for (int k = 0; k < 2; ++k) \
        acc[ai][bj][m][n] = __builtin_amdgcn_mfma_f32_16x16x32_bf16(Bt[n][k], At[m][k], acc[ai][bj][m][n], 0, 0, 0); __builtin_amdgcn_s_setprio(0); } while (0)
#define PG8_WAIT_V(n) asm volatile("s_waitcnt vmcnt(" #n ")" ::: "memory")
#define PG8_WAIT_L(n) asm volatile("s_waitcnt lgkmcnt(" #n ")" ::: "memory")
#define PG8_BAR __builtin_amdgcn_s_barrier()
#define PG8_SCHED __builtin_amdgcn_sched_barrier(0)
    Unit cur, nxt; int ui = 0;
    if (!S.next(0, cur)) return;
    if constexpr (Epi::NEED_RS) {
        LAS float* rst = (LAS float*)(lds + STAGE_BYTES); Unit uu;
        for (int i0 = 0; S.next(i0, uu); i0 += 2) { const int i = i0 + (tid >> 8); if (S.next(i, uu)) rst[i * 256 + (tid & 255)] = row_rs(E.ss, uu.pm * BM + (tid & 255)); }
    }
    f32x4 acc[2][2][4][2];
#pragma unroll
    for (int a = 0; a < 2; ++a)
#pragma unroll
        for (int b = 0; b < 2; ++b)
#pragma unroll
            for (int m = 0; m < 4; ++m)
#pragma unroll
                for (int n = 0; n < 2; ++n) acc[a][b][m][n] = (f32x4){0.f, 0.f, 0.f, 0.f};
    bf16x8 At[4][2], B0[2][2], B1[2][2];
    const char* cA = (const char*)g.A + (size_t)cur.pm * tstepA; const char* cB = (const char*)g.Bt + (size_t)cur.pn * tstepB;
    PG8_STAGE(PG8_SB(0, 0), cB, voffB); PG8_STAGE(PG8_SB(0, 1), cB + hstepB, voffB); PG8_STAGE(PG8_SA(0, 0), cA, voffA); PG8_STAGE(PG8_SA(0, 1), cA + hstepA, voffA);
    if (wr == 1) PG8_BAR;
    PG8_WAIT_V(2); PG8_BAR;
    PG8_STAGE(PG8_SB(1, 0), cB + kstep, voffB); PG8_STAGE(PG8_SA(1, 0), cA + kstep, voffA); PG8_STAGE(PG8_SB(1, 1), cB + hstepB + kstep, voffB);
    PG8_WAIT_V(6); PG8_BAR;
    for (;;) {
        const bool has_next = S.next(ui + 1, nxt);
        const char* nA = has_next ? (const char*)g.A + (size_t)nxt.pm * tstepA : cA; const char* nB = has_next ? (const char*)g.Bt + (size_t)nxt.pn * tstepB : cB;
        for (int t = 0; t < nt; t += 2) {
            const bool last = (t == nt - 2);
            const char* a1 = cA + (size_t)(t + 1) * kstep;
            const char* a2 = last ? nA : cA + (size_t)(t + 2) * kstep; const char* b2 = last ? nB : cB + (size_t)(t + 2) * kstep;
            const char* a3 = a2 + kstep; const char* b3 = b2 + kstep;
            PG8_LDB(B0, 0, 0); PG8_LDB(B1, 0, 1); PG8_SCHED; PG8_LDA(At, 0, 0); PG8_STAGE(PG8_SA(1, 1), a1 + hstepA, voffA);
            PG8_WAIT_V(8); PG8_WAIT_L(0); PG8_BAR; PG8_MMA(0, 0, At, B0); PG8_MMA(0, 1, At, B1); PG8_BAR; PG8_SCHED;
            PG8_LDA(At, 0, 1); PG8_STAGE(PG8_SB(0, 0), b2, voffB); PG8_STAGE(PG8_SB(0, 1), b2 + hstepB, voffB); PG8_STAGE(PG8_SA(0, 0), a2, voffA);
            PG8_WAIT_V(8); PG8_WAIT_L(0); PG8_BAR; PG8_MMA(1, 0, At, B0); PG8_MMA(1, 1, At, B1); PG8_BAR; PG8_SCHED;
            PG8_LDB(B0, 1, 0); PG8_LDB(B1, 1, 1); PG8_SCHED; PG8_LDA(At, 1, 0); PG8_STAGE(PG8_SA(0, 1), a2 + hstepA, voffA);
            PG8_WAIT_V(8); PG8_WAIT_L(0); PG8_BAR; PG8_MMA(0, 0, At, B0); PG8_MMA(0, 1, At, B1); PG8_BAR; PG8_SCHED;
            PG8_LDA(At, 1, 1); PG8_STAGE(PG8_SB(1, 0), b3, voffB); PG8_STAGE(PG8_SB(1, 1), b3 + hstepB, voffB); PG8_STAGE(PG8_SA(1, 0), a3, voffA);
            PG8_WAIT_V(8); PG8_WAIT_L(0); PG8_BAR; PG8_MMA(1, 0, At, B0); PG8_MMA(1, 1, At, B1); PG8_BAR; PG8_SCHED;
        }
        if (wr == 0) PG8_BAR;
        E(acc, cur, wr, wc, fr, fq, (const LAS float*)(lds + STAGE_BYTES) + ui * 256);
        if (!has_next) break;
#pragma unroll
        for (int a = 0; a < 2; ++a)
#pragma unroll
            for (int b = 0; b < 2; ++b)
#pragma unroll
                for (int m = 0; m < 4; ++m)
#pragma unroll
                    for (int n = 0; n < 2; ++n) acc[a][b][m][n] = (f32x4){0.f, 0.f, 0.f, 0.f};
        cur = nxt; cA = nA; cB = nB; ++ui;
        if (wr == 1) PG8_BAR;
    }
    PG8_WAIT_V(0);
    PG8_BAR;
#undef PG8_SA
#undef PG8_SB
#undef PG8_STAGE
#undef PG8_LDA
#undef PG8_LDB
#undef PG8_MMA
#undef PG8_WAIT_V
#undef PG8_WAIT_L
#undef PG8_BAR
#undef PG8_SCHED
}

struct EpiIn { static constexpr bool NEED_RS = true;
    bf16_t* P; const float* ss;
    __device__ __forceinline__ void operator()(const f32x4 (&acc)[2][2][4][2], const Unit& u, int wr, int wc, int fr, int fq, const LAS float* rsl) const {
        const int row0 = u.pm * BM + wr * 64 + fr, col0 = u.pn * BM + wc * 32 + 8 * fq; const bool act = u.pn >= 4;
#pragma unroll
        for (int ai = 0; ai < 2; ++ai)
#pragma unroll
            for (int m = 0; m < 4; ++m) { const int row = row0 + ai * HALF + m * 16; const float rs = rsl[ai * HALF + wr * 64 + m * 16 + fr];
                bf16_t* rowp = P + (size_t)row * NIN + col0;
#pragma unroll
                for (int bj = 0; bj < 2; ++bj) { f32x4 v0 = acc[ai][bj][m][0] * rs, v1 = acc[ai][bj][m][1] * rs;
                    if (act) { f32x4 t0 = v0 * (v0 * v0 * 0.044715f + 1.f), t1 = v1 * (v1 * v1 * 0.044715f + 1.f);
                        sigm8(t0, t1, -2.f * 0.7978845608f * 1.4426950409f); v0 = v0 * t0; v1 = v1 * t1; }
                    u32x4 w; w.x = cvt_pk_bf16(v0[0], v0[1]); w.y = cvt_pk_bf16(v0[2], v0[3]); w.z = cvt_pk_bf16(v1[0], v1[1]); w.w = cvt_pk_bf16(v1[2], v1[3]);
                    *(u32x4*)(rowp + bj * HALF) = w; } }
    }
};
struct EpiQKV { static constexpr bool NEED_RS = true;
    bf16_t* O; const float* ss; const float* rope; bf16_t* VT;
    __device__ __forceinline__ void operator()(const f32x4 (&acc)[2][2][4][2], const Unit& u, int wr, int wc, int fr, int fq, const LAS float* rsl) const {
        const int row0 = u.pm * BM + wr * 64 + fr;
        if (u.pn < 5) {
            const int dlo = 16 * (wc & 1) + 4 * fq;
#pragma unroll
            for (int ai = 0; ai < 2; ++ai) {
                f32x4 cs[4], sn[4];
#pragma unroll
                for (int m = 0; m < 4; ++m) { const int pos = (row0 + ai * HALF + m * 16) & (SEQ - 1); cs[m] = *(const f32x4*)(rope + (size_t)pos * 32 + dlo); sn[m] = *(const f32x4*)(rope + (size_t)SEQ * 32 + (size_t)pos * 32 + dlo); }
#pragma unroll
                for (int m = 0; m < 4; ++m) { const int row = row0 + ai * HALF + m * 16; const float rs = rsl[ai * HALF + wr * 64 + m * 16 + fr];
#pragma unroll
                    for (int bj = 0; bj < 2; ++bj) { const f32x4 x1 = acc[ai][bj][m][0] * rs, x2 = acc[ai][bj][m][1] * rs;
                        const f32x4 o1 = x1 * cs[m] - x2 * sn[m], o2 = x2 * cs[m] + x1 * sn[m];
                        bf16_t* dst = O + (size_t)row * NQKV + u.pn * BM + (2 * bj + (wc >> 1)) * 64 + dlo;
                        u32x2 w1, w2; w1.x = cvt_pk_bf16(o1[0], o1[1]); w1.y = cvt_pk_bf16(o1[2], o1[3]); w2.x = cvt_pk_bf16(o2[0], o2[1]); w2.y = cvt_pk_bf16(o2[2], o2[3]);
                        *(u32x2*)dst = w1; *(u32x2*)(dst + 32) = w2; } } }
        } else {
            const int c0 = wc * 32 + 8 * fq;
#pragma unroll
            for (int ai = 0; ai < 2; ++ai)
#pragma unroll
                for (int m = 0; m < 4; ++m) { const int row = row0 + ai * HALF + m * 16; const float rs = rsl[ai * HALF + wr * 64 + m * 16 + fr]; const int bidx = row >> 12, t = row & (SEQ - 1);
#pragma unroll
                    for (int bj = 0; bj < 2; ++bj) { const f32x4 v0 = acc[ai][bj][m][0] * rs, v1 = acc[ai][bj][m][1] * rs; const int c = c0 + bj * HALF;
                        bf16_t* dst = VT + ((size_t)bidx * 256 + c) * SEQ + t;
                        const unsigned w0 = cvt_pk_bf16(v0[0], v0[1]), w1 = cvt_pk_bf16(v0[2], v0[3]), w2 = cvt_pk_bf16(v1[0], v1[1]), w3 = cvt_pk_bf16(v1[2], v1[3]);
                        dst[0] = (bf16_t)(w0 & 0xffffu); dst[SEQ] = (bf16_t)(w0 >> 16); dst[2 * SEQ] = (bf16_t)(w1 & 0xffffu); dst[3 * SEQ] = (bf16_t)(w1 >> 16);
                        dst[4 * SEQ] = (bf16_t)(w2 & 0xffffu); dst[5 * SEQ] = (bf16_t)(w2 >> 16); dst[6 * SEQ] = (bf16_t)(w3 & 0xffffu); dst[7 * SEQ] = (bf16_t)(w3 >> 16); } }
        }
    }
};
struct EpiGU { static constexpr bool NEED_RS = true;
    bf16_t* O; const float* ss;
    __device__ __forceinline__ void operator()(const f32x4 (&acc)[2][2][4][2], const Unit& u, int wr, int wc, int fr, int fq, const LAS float* rsl) const {
        const int row0 = u.pm * BM + wr * 64 + fr, col0 = u.pn * HALF + wc * 32 + 8 * fq;
#pragma unroll
        for (int ai = 0; ai < 2; ++ai)
#pragma unroll
            for (int m = 0; m < 4; ++m) { const int row = row0 + ai * HALF + m * 16; const float rs = rsl[ai * HALF + wr * 64 + m * 16 + fr];
                const f32x4 g0 = acc[ai][0][m][0] * rs, g1 = acc[ai][0][m][1] * rs; f32x4 t0 = g0, t1 = g1;
                sigm8(t0, t1, -1.4426950409f);
                const f32x4 a0 = g0 * t0 * (acc[ai][1][m][0] * rs), a1 = g1 * t1 * (acc[ai][1][m][1] * rs);
                u32x4 w; w.x = cvt_pk_bf16(a0[0], a0[1]); w.y = cvt_pk_bf16(a0[2], a0[3]); w.z = cvt_pk_bf16(a1[0], a1[1]); w.w = cvt_pk_bf16(a1[2], a1[3]);
                *(u32x4*)(O + (size_t)row * DFF + col0) = w; }
    }
};
struct EpiRes { static constexpr bool NEED_RS = false;
    bf16_t* xb; float* ss;
    __device__ __forceinline__ void operator()(const f32x4 (&acc)[2][2][4][2], const Unit& u, int wr, int wc, int fr, int fq, const LAS float* rsl) const {
        const int row0 = u.pm * BM + wr * 64 + fr, col0 = u.pn * BM + wc * 32 + 8 * fq;
        u32x4 bw0[4][2], bw1[4][2];
#pragma unroll
        for (int m = 0; m < 4; ++m)
#pragma unroll
            for (int bj = 0; bj < 2; ++bj) bw0[m][bj] = *(const u32x4*)(xb + (size_t)(row0 + m * 16) * DM + col0 + bj * HALF);
#pragma unroll
        for (int ai = 0; ai < 2; ++ai) {
#pragma unroll
            for (int m = 0; m < 4; ++m) { const int row = row0 + ai * HALF + m * 16; const size_t off = (size_t)row * DM + col0; float s = 0.f;
                if (ai == 0 && m == 2) {
#pragma unroll
                    for (int m2 = 0; m2 < 4; ++m2)
#pragma unroll
                        for (int bj = 0; bj < 2; ++bj) bw1[m2][bj] = *(const u32x4*)(xb + (size_t)(row0 + HALF + m2 * 16) * DM + col0 + bj * HALF); }
#pragma unroll
                for (int bj = 0; bj < 2; ++bj) { const size_t o = off + bj * HALF; const u32x4 b = ai == 0 ? bw0[m][bj] : bw1[m][bj];
                    const f32x4 v0 = acc[ai][bj][m][0] + (f32x4){bflo(b.x), bfhi(b.x), bflo(b.y), bfhi(b.y)}, v1 = acc[ai][bj][m][1] + (f32x4){bflo(b.z), bfhi(b.z), bflo(b.w), bfhi(b.w)};
                    u32x4 w; w.x = cvt_pk_bf16(v0[0], v0[1]); w.y = cvt_pk_bf16(v0[2], v0[3]); w.z = cvt_pk_bf16(v1[0], v1[1]); w.w = cvt_pk_bf16(v1[2], v1[3]);
                    *(u32x4*)(xb + o) = w;
                    s += (v0[0] * v0[0] + v0[1] * v0[1]) + (v0[2] * v0[2] + v0[3] * v0[3]) + (v1[0] * v1[0] + v1[1] * v1[1]) + (v1[2] * v1[2] + v1[3] * v1[3]); }
                s += __shfl_xor(s, 16); s += __shfl_xor(s, 32);
                if (fq == 0) ss[(size_t)row * 16 + u.pn * 4 + wc] = s; } }
    }
};
}

struct Params {
    const float *x, *mix_norm, *ffn_norm, *final_norm, *even_w_in, *even_conv_w, *even_conv_b, *lru_w_r, *lru_b_r, *lru_w_i, *lru_b_i, *lru_lambda,
                *sg_ln_g, *sg_ln_b, *sg_w, *sg_b, *even_w_out, *attn_w_qkv, *attn_sinks, *attn_w_o, *ffn_w_gu, *ffn_w_down;
    float* out; unsigned char* ws; int ph_lo, ph_hi;
};

typedef const __attribute__((address_space(4))) Params* KP;
__device__ __forceinline__ int tid_opaque() { int t = threadIdx.x; asm volatile("" : "+v"(t)); return t; }
#define LDS_WAIT() asm volatile("s_waitcnt lgkmcnt(0)" ::: "memory")

__device__ __forceinline__ int phys32(int l) { return 16 * ((l >> 2) & 1) + 4 * (l >> 3) + (l & 3); }
__device__ __forceinline__ int map_col(int mode, int n) {
    if (mode == 0) return (n & ~31) | phys32(n & 31);
    if (mode == 1) { if (n >= 1280) return (n & ~31) | phys32(n & 31);
        const int tile = n >> 8, c = n & 255, head = c >> 6, d = c & 63, nn = d >> 5, r = d & 31, wcl = r >> 4, fq = (r >> 2) & 3, j = r & 3, bj = head >> 1, wc = 2 * (head & 1) + wcl;
        return tile * 256 + 128 * bj + 32 * wc + 16 * nn + 4 * fq + j; }
    if (mode == 2) { const int isu = n >= DFF ? 1 : 0, f = n - isu * DFF, pn = f >> 7, r = f & 127, wc = r >> 5, l = r & 31; return 256 * pn + 128 * isu + 32 * wc + phys32(l); }
    return n;
}
struct TrD { const float* W; const float* g; bf16_t* WT; int K, N, qcols, mode, r; float wscale; };
__device__ __forceinline__ void tr_load(const TrD& d, int lane, f32x4 (&v)[8]) {
    const int nblk = d.N / 32, kb = d.r / nblk, nb = d.r % nblk, k0 = 64 * kb, n0 = 32 * nb, nq = 4 * (lane & 7);
#pragma unroll
    for (int i = 0; i < 8; ++i) { const int kk = 8 * i + (lane >> 3); v[i] = *(const f32x4*)(d.W + (size_t)(k0 + kk) * d.N + n0 + nq); }
}
__device__ __forceinline__ void tr_finish(const TrD& d, int lane, const f32x4 (&v)[8], float* scr) {
    const int nblk = d.N / 32, kb = d.r / nblk, nb = d.r % nblk, k0 = 64 * kb, n0 = 32 * nb, nq = 4 * (lane & 7), K = d.K;
#pragma unroll
    for (int i = 0; i < 8; ++i) { const int kk = 8 * i + (lane >> 3); const float gs = d.g ? d.g[k0 + kk] : 1.0f; float* t = scr + kk * 33 + nq;
        t[0] = v[i][0] * gs; t[1] = v[i][1] * gs; t[2] = v[i][2] * gs; t[3] = v[i][3] * gs; }
    LDS_WAIT();
    const int c = lane & 7;
#pragma unroll
    for (int j = 0; j < 4; ++j) { const int n = (lane >> 3) + 8 * j; const float* s = scr + (8 * c) * 33 + n; const float sc = (n0 + n) < d.qcols ? 0.125f * 1.4426950409f : d.wscale;
        u32x4 o; o.x = cvt_pk_bf16(s[0 * 33] * sc, s[1 * 33] * sc); o.y = cvt_pk_bf16(s[2 * 33] * sc, s[3 * 33] * sc); o.z = cvt_pk_bf16(s[4 * 33] * sc, s[5 * 33] * sc); o.w = cvt_pk_bf16(s[6 * 33] * sc, s[7 * 33] * sc);
        *(u32x4*)(d.WT + (size_t)map_col(d.mode, n0 + n) * K + k0 + 8 * c) = o; }
    LDS_WAIT();
}
__device__ __forceinline__ void prologue(KP p, unsigned char* lds) {
    const int tid = tid_opaque(), lane = tid & 63, wave = tid >> 6, G = gridDim.x;
    const int gw = blockIdx.x * 8 + wave, NGW = G * 8;
    unsigned char* ws = p->ws;
    float* scr = (float*)(lds + wave * 8448);
    constexpr int I_IN = 16 * 128, I_OUT = 32 * 32, I_QKV = 16 * 48, I_O = 16 * 32, I_GU = 16 * 176, I_DN = 44 * 32, I_G = 2 * 4;
    constexpr int T0 = 2 * I_IN, T1 = T0 + 2 * I_OUT, T2 = T1 + 2 * I_QKV, T3 = T2 + 2 * I_O, T4 = T3 + 4 * I_GU, T5 = T4 + 4 * I_DN, T6 = T5 + 64 * I_G;
#define TR_DESC(D, IT) do { const int it_ = (IT); \
        if (it_ < T0) { const int j = it_ / I_IN; D = TrD{p->even_w_in + (size_t)j * DM * NIN, p->mix_norm + (2 * j) * DM, (bf16_t*)(ws + OFF_WIN) + (size_t)j * NIN * DM, DM, NIN, 0, 0, it_ % I_IN, 1.0f}; } \
        else if (it_ < T1) { const int q = it_ - T0, j = q / I_OUT; D = TrD{p->even_w_out + (size_t)j * KOUT * DM, nullptr, (bf16_t*)(ws + OFF_WOUT) + (size_t)j * DM * KOUT, KOUT, DM, 0, 0, q % I_OUT, 1.0f}; } \
        else if (it_ < T2) { const int q = it_ - T1, j = q / I_QKV; D = TrD{p->attn_w_qkv + (size_t)j * DM * NQKV, p->mix_norm + (2 * j + 1) * DM, (bf16_t*)(ws + OFF_WQKV) + (size_t)j * NQKV * DM, DM, NQKV, 1024, 1, q % I_QKV, 1.0f}; } \
        else if (it_ < T3) { const int q = it_ - T2, j = q / I_O; D = TrD{p->attn_w_o + (size_t)j * DM * DM, nullptr, (bf16_t*)(ws + OFF_WO) + (size_t)j * DM * DM, DM, DM, 0, 0, q % I_O, 1.0f}; } \
        else if (it_ < T4) { const int q = it_ - T3, l = q / I_GU; D = TrD{p->ffn_w_gu + (size_t)l * DM * NGU, p->ffn_norm + l * DM, (bf16_t*)(ws + OFF_WGU) + (size_t)l * NGU * DM, DM, NGU, 0, 2, q % I_GU, 1.0f}; } \
        else if (it_ < T5) { const int q = it_ - T4, l = q / I_DN; D = TrD{p->ffn_w_down + (size_t)l * DFF * DM, nullptr, (bf16_t*)(ws + OFF_WDN) + (size_t)l * DM * DFF, DFF, DM, 0, 0, q % I_DN, 1.0f}; } \
        else { const int q = it_ - T5, mi = q / I_G, ri = mi & 1, head = (mi >> 1) & 7, dir = (mi >> 4) & 1, j = mi >> 5;        \
            D = TrD{(ri ? p->lru_w_i : p->lru_w_r) + (size_t)((j * 2 + dir) * 8 + head) * 16384, nullptr, (bf16_t*)(ws + OFF_WG) + ((size_t)(j * 8 + head) * 512 + (dir * 2 + ri) * 128) * 128, 128, 128, 0, 3, q % I_G, -1.4426950409f}; } } while (0)
    for (int it = gw; it < T6; it += 2 * NGW) {
        TrD d0, d1; f32x4 v0[8], v1[8]; const bool two = it + NGW < T6;
        TR_DESC(d0, it); tr_load(d0, lane, v0);
        if (two) { TR_DESC(d1, it + NGW); tr_load(d1, lane, v1); }
        tr_finish(d0, lane, v0, scr);
        if (two) tr_finish(d1, lane, v1, scr);
    }
#undef TR_DESC
    const int gt = blockIdx.x * 512 + tid, NT = G * 512;
    { bf16_t* dst = (bf16_t*)(ws + OFF_WSG); for (int i = gt; i < 2 * 8 * 128 * 128 / 2; i += NT) { const f32x2 v = *(const f32x2*)(p->sg_w + 2 * (size_t)i); *(unsigned*)(dst + 2 * (size_t)i) = cvt_pk_bf16(v.x, v.y); } }
    { float* rc = (float*)(ws + OFF_ROPE); for (int i = gt; i < SEQ * 32; i += NT) { const int pos = i >> 5, f = i & 31;
        const float freq = __builtin_amdgcn_exp2f(-(float)f * (13.287712379549449f / 32.0f)); const float ang = (float)pos * freq;
        const double rev = (double)ang * 0.15915494309189535; const float fr = (float)(rev - __builtin_rint(rev));
        rc[i] = __builtin_amdgcn_cosf(fr); rc[SEQ * 32 + i] = __builtin_amdgcn_sinf(fr); } }
    { bf16_t* xb = (bf16_t*)(ws + OFF_XB); float* ss = (float*)(ws + OFF_SSP);
      for (int m0 = gw; m0 < MTOK; m0 += 4 * NGW) { f32x4 v[4][4];
#pragma unroll
        for (int r = 0; r < 4; ++r) { const int m = m0 + r * NGW; if (m < MTOK) { const f32x4* xr = (const f32x4*)(p->x + (size_t)m * DM) + lane;
#pragma unroll
            for (int j = 0; j < 4; ++j) v[r][j] = xr[64 * j]; } }
#pragma unroll
        for (int r = 0; r < 4; ++r) { const int m = m0 + r * NGW; if (m < MTOK) { float s = 0.f; u32x2* o8 = (u32x2*)(xb + (size_t)m * DM) + lane;
#pragma unroll
            for (int j = 0; j < 4; ++j) { const f32x4 q = v[r][j]; s += (q.x * q.x + q.y * q.y) + (q.z * q.z + q.w * q.w); u32x2 w; w.x = cvt_pk_bf16(q.x, q.y); w.y = cvt_pk_bf16(q.z, q.w); o8[64 * j] = w; }
            s = wave_sum(s); if (lane < 16) ss[(size_t)m * 16 + lane] = lane == 0 ? s : 0.f; } } } }
}

constexpr int LCH = 64, AUP = 132, XCP = 136;
__device__ __forceinline__ void lru_phase(KP p, int j, int pass, unsigned char* lds) {
    const int tid = tid_opaque(), lane = tid & 63, wave = tid >> 6, fr = lane & 15, fq = lane >> 4, G = gridDim.x;
    bf16_t* P = (bf16_t*)(p->ws + OFF_R1);
    float* agg = (float*)(p->ws + OFF_AGG);
    float* AF = (float*)lds; float* AB = AF + LCH * AUP;
    bf16_t* UF = (bf16_t*)(lds + 2 * LCH * AUP * 4); bf16_t* UB = UF + LCH * XCP;
    bf16_t* xcb = UB + LCH * XCP;
    bf16_t* xs = xcb + LCH * XCP;
    float* cbw = (float*)(xs + 68 * 128);
    const float* cw = p->even_conv_w + (size_t)j * 4 * DM; const float* cb = p->even_conv_b + (size_t)j * DM;
    const float NL2E = -1.4426950409f;
    for (int unit = blockIdx.x; unit < BATCH * 8 * 4; unit += G) {
      const int h = unit & 7, cq = (unit >> 3) & 3, b = unit >> 5, cfirst = cq * 16;
      const size_t abase = (size_t)b * 64 * 4 * DM + h * 128 + (tid & 127);
      float hcarry = 0.f;
      if (pass == 1 && tid < 256) {
          if (tid < 128) {
#pragma unroll 1
              for (int kb = 0; kb < cfirst; kb += 16) { float av[16], hv[16];
#pragma unroll
                  for (int i = 0; i < 16; ++i) { av[i] = agg[abase + (size_t)(((kb + i) * 2 + 0) * 2 + 0) * DM]; hv[i] = agg[abase + (size_t)(((kb + i) * 2 + 0) * 2 + 1) * DM]; }
#pragma unroll
                  for (int i = 0; i < 16; ++i) hcarry = av[i] * hcarry + hv[i]; }
          } else { float hc = 0.f;
#pragma unroll 1
              for (int kb = 63; kb >= cfirst; kb -= 16) { float av[16], hv[16]; const bool mine = (kb - 15 == cfirst);
#pragma unroll
                  for (int i = 0; i < 16; ++i) { av[i] = agg[abase + (size_t)(((kb - i) * 2 + 1) * 2 + 0) * DM]; hv[i] = agg[abase + (size_t)(((kb - i) * 2 + 1) * 2 + 1) * DM]; }
#pragma unroll
                  for (int i = 0; i < 16; ++i) { if (mine) cbw[(15 - i) * 128 + (tid & 127)] = hc; hc = av[i] * hc + hv[i]; } } }
      }
      const int ch2 = tid & 63, tg = (tid >> 6) & 3, cch = h * 128 + 2 * ch2; float w0[4], w1[4];
#pragma unroll
      for (int k = 0; k < 4; ++k) { w0[k] = cw[k * DM + cch]; w1[k] = cw[k * DM + cch + 1]; }
      const float cb0 = cb[cch], cb1 = cb[cch + 1];
      const int cs = 16 * wave, chl = cs + 4 * fq;
      float* gct = cbw + 16 * 128;
      if (tid < 128) { const int chg1 = h * 128 + tid;
          gct[0 * 128 + tid] = NL2E * p->lru_b_r[(size_t)(j * 2 + 0) * DM + chg1]; gct[1 * 128 + tid] = NL2E * p->lru_b_i[(size_t)(j * 2 + 0) * DM + chg1];
          gct[2 * 128 + tid] = NL2E * p->lru_b_r[(size_t)(j * 2 + 1) * DM + chg1]; gct[3 * 128 + tid] = NL2E * p->lru_b_i[(size_t)(j * 2 + 1) * DM + chg1];
          gct[4 * 128 + tid] = -8.f * 1.4426950409f * log1pf(__expf(-p->lru_lambda[(size_t)(j * 2 + 0) * DM + chg1])); gct[5 * 128 + tid] = -8.f * 1.4426950409f * log1pf(__expf(-p->lru_lambda[(size_t)(j * 2 + 1) * DM + chg1])); }
      const bf16_t* Wg = (const bf16_t*)(p->ws + OFF_WG) + (size_t)(j * 8 + h) * 512 * 128;
#define LRU_LOAD_PRE(T0) do { _Pragma("unroll") for (int i = 0; i < 3; ++i) { const int q = tid + 512 * i, rr = q >> 4, c8 = (q & 15) * 8, t = (T0) - 2 + rr; pre[i] = (u32x4){0u, 0u, 0u, 0u}; \
            if (q < 68 * 16 && t >= 0 && t < SEQ) pre[i] = *(const u32x4*)(P + ((size_t)b * SEQ + t) * NIN + h * 128 + c8); } } while (0)
#define LRU_STORE_PRE() do { _Pragma("unroll") for (int i = 0; i < 3; ++i) { const int q = tid + 512 * i, rr = q >> 4, c8 = (q & 15) * 8; if (q < 68 * 16) *(u32x4*)(xs + rr * 128 + c8) = pre[i]; } } while (0)
#define LRU_CONV() do { unsigned xr_[19]; _Pragma("unroll") for (int i = 0; i < 19; ++i) xr_[i] = *(const unsigned*)(xs + (tg * 16 + i) * 128 + 2 * ch2);     \
        _Pragma("unroll") for (int i = 0; i < 16; ++i) { const int t = tg * 16 + i; float y0 = cb0, y1 = cb1; \
            _Pragma("unroll") for (int k = 0; k < 4; ++k) { const unsigned w = xr_[i + k]; y0 += w0[k] * bflo(w); y1 += w1[k] * bfhi(w); } \
            *(unsigned*)(xcb + t * XCP + 2 * ch2) = cvt_pk_bf16(y0, y1); } } while (0)
      u32x4 pre[3];
      LRU_LOAD_PRE(cfirst * LCH);
      LRU_STORE_PRE();
      LRU_LOAD_PRE((cfirst + 1) * LCH);
      __syncthreads();
      if (wave >= 4) LRU_CONV();
      __syncthreads();
      for (int ci = 0; ci < 16; ++ci) {
        const int c = cfirst + ci, t0 = c * LCH; const size_t row0 = (size_t)b * SEQ + t0;
        if (ci < 15) LRU_STORE_PRE();
        { bf16x8 wd[2][4][2];
#pragma unroll
          for (int ks = 0; ks < 4; ++ks)
#pragma unroll
            for (int g = 0; g < 2; ++g) wd[0][ks][g] = *(const bf16x8*)(Wg + (size_t)(g * 128 + cs + fr) * 128 + 32 * ks + 8 * fq);
#pragma unroll
          for (int d = 0; d < 2; ++d) {
            f32x4 acc[2][4];
#pragma unroll
            for (int g = 0; g < 2; ++g)
#pragma unroll
              for (int m = 0; m < 4; ++m) acc[g][m] = (f32x4){0.f, 0.f, 0.f, 0.f};
            if (d == 0) {
#pragma unroll
              for (int ks = 0; ks < 4; ++ks)
#pragma unroll
                for (int g = 0; g < 2; ++g) wd[1][ks][g] = *(const bf16x8*)(Wg + (size_t)((2 + g) * 128 + cs + fr) * 128 + 32 * ks + 8 * fq); }
#pragma unroll
            for (int ks = 0; ks < 4; ++ks) { bf16x8 xf[4];
#pragma unroll
              for (int m = 0; m < 4; ++m) xf[m] = *(const bf16x8*)(xcb + (16 * m + fr) * XCP + 32 * ks + 8 * fq);
#pragma unroll
              for (int g = 0; g < 2; ++g)
#pragma unroll
                for (int m = 0; m < 4; ++m) acc[g][m] = __builtin_amdgcn_mfma_f32_16x16x32_bf16(wd[d][ks][g], xf[m], acc[g][m], 0, 0, 0); }
            const f32x4 br = *(const f32x4*)(gct + (2 * d) * 128 + chl), bi = *(const f32x4*)(gct + (2 * d + 1) * 128 + chl), ns = *(const f32x4*)(gct + (4 + d) * 128 + chl);
            float* Ad = d == 0 ? AF : AB; bf16_t* Ud = d == 0 ? UF : UB;
#pragma unroll
            for (int m = 0; m < 4; ++m) { const int tok = 16 * m + fr; const u32x2 xw = *(const u32x2*)(xcb + tok * XCP + chl);
                const f32x4 xv = (f32x4){bflo(xw.x), bfhi(xw.x), bflo(xw.y), bfhi(xw.y)}; f32x4 av, uv;
                { f32x4 e1 = acc[0][m] + br, e2 = acc[1][m] + bi;
#pragma unroll
                  for (int jj = 0; jj < 4; ++jj) { e1[jj] = __builtin_amdgcn_exp2f(fminf(e1[jj], 60.f)); e2[jj] = __builtin_amdgcn_exp2f(fminf(e2[jj], 60.f)); }
                  const f32x4 d1 = e1 + 1.f, d2 = e2 + 1.f; f32x4 tq = d1 * d2;
#pragma unroll
                  for (int jj = 0; jj < 4; ++jj) tq[jj] = __builtin_amdgcn_rcpf(tq[jj]);
                  const f32x4 la = (tq * d2) * ns, ig = tq * d1;
#pragma unroll
                  for (int jj = 0; jj < 4; ++jj) av[jj] = __builtin_amdgcn_exp2f(la[jj]);
                  f32x4 mq = 1.f - av * av;
#pragma unroll
                  for (int jj = 0; jj < 4; ++jj) mq[jj] = __builtin_amdgcn_sqrtf(fmaxf(mq[jj], 0.f));
                  uv = mq * ig * xv; }
                *(f32x4*)(Ad + tok * AUP + chl) = av;
                u32x2 pu; pu.x = cvt_pk_bf16(uv[0], uv[1]); pu.y = cvt_pk_bf16(uv[2], uv[3]);
                *(u32x2*)(Ud + tok * XCP + chl) = pu; } } }
        __syncthreads();
        if (ci < 14) LRU_LOAD_PRE(t0 + 2 * LCH);
        u32x4 gpre[2];
        if (pass == 1) {
#pragma unroll
            for (int i = 0; i < 2; ++i) { const int q = tid + 512 * i, t = q >> 4, c8 = (q & 15) * 8; gpre[i] = *(const u32x4*)(P + (row0 + t) * NIN + DM + h * 128 + c8); } }
        if (tid < 256) { const int ch = tid & 127, dir = tid >> 7; const float* A = (dir ? AB : AF) + ch; bf16_t* U = (dir ? UB : UF) + ch;
            float hcur = 0.f;
            if (pass == 1) hcur = dir == 0 ? hcarry : cbw[ci * 128 + ch];
            float ap = 1.f;
#define LRU_SCAN(T0, SGN) do { _Pragma("unroll") for (int tb = 0; tb < LCH; tb += 16) { float av[16], uv[16]; \
                const float* Ab = A + ((T0) + (SGN) * tb) * AUP; bf16_t* Ub = U + ((T0) + (SGN) * tb) * XCP; \
                _Pragma("unroll") for (int i = 0; i < 16; ++i) { av[i] = Ab[(SGN) * i * AUP]; uv[i] = bf2f(Ub[(SGN) * i * XCP]); } \
                _Pragma("unroll") for (int i = 0; i < 16; ++i) { hcur = av[i] * hcur + uv[i]; ap *= av[i]; uv[i] = hcur; } \
                if (pass == 1) { _Pragma("unroll") for (int i = 0; i < 16; ++i) Ub[(SGN) * i * XCP] = (bf16_t)(cvt_pk_bf16(uv[i], uv[i]) & 0xffffu); } } } while (0)
            if (dir == 0) LRU_SCAN(0, 1); else LRU_SCAN(LCH - 1, -1);
#undef LRU_SCAN
            if (pass == 0) { agg[abase + (size_t)((c * 2 + dir) * 2 + 0) * DM] = ap; agg[abase + (size_t)((c * 2 + dir) * 2 + 1) * DM] = hcur; }
            else if (dir == 0) hcarry = hcur;
        } else if (ci < 15) { LRU_CONV(); }
        __syncthreads();
        if (pass == 1) {
#pragma unroll
            for (int i = 0; i < 2; ++i) { const int q = tid + 512 * i, t = q >> 4, c8 = (q & 15) * 8; bf16_t* gp = P + (row0 + t) * NIN + DM + h * 128 + c8; const u32x4 gw = gpre[i];
                const u32x4 hf = *(const u32x4*)(UF + t * XCP + c8), hb = *(const u32x4*)(UB + t * XCP + c8);
                u32x4 w; w.x = cvt_pk_bf16(bflo(gw.x) * (bflo(hf.x) + bflo(hb.x)), bfhi(gw.x) * (bfhi(hf.x) + bfhi(hb.x))); w.y = cvt_pk_bf16(bflo(gw.y) * (bflo(hf.y) + bflo(hb.y)), bfhi(gw.y) * (bfhi(hf.y) + bfhi(hb.y)));
                w.z = cvt_pk_bf16(bflo(gw.z) * (bflo(hf.z) + bflo(hb.z)), bfhi(gw.z) * (bfhi(hf.z) + bfhi(hb.z))); w.w = cvt_pk_bf16(bflo(gw.w) * (bflo(hf.w) + bflo(hb.w)), bfhi(gw.w) * (bfhi(hf.w) + bfhi(hb.w)));
                *(u32x4*)gp = w; }
            __syncthreads();
        }
      }
#undef LRU_LOAD_PRE
#undef LRU_STORE_PRE
#undef LRU_CONV
    }
}

constexpr int VTP = 136;
typedef short v4i16_t __attribute__((ext_vector_type(4)));
__device__ __forceinline__ void sg_phase(KP p, int j, unsigned char* lds) {
    const int tid = tid_opaque(), lane = tid & 63, wave = tid >> 6, fr = lane & 15, fq = lane >> 4, G = gridDim.x;
    bf16_t* P = (bf16_t*)(p->ws + OFF_R1);
    bf16_t* vr = (bf16_t*)lds;
    float* mu = (float*)(lds + 128 * VTP * 2); float* rstd = mu + 128;
    const float* lng = p->sg_ln_g + (size_t)j * DM; const float* lnb = p->sg_ln_b + (size_t)j * DM;
    const int c8 = (tid & 15) * 8;
    for (int item = blockIdx.x; item < BATCH * 32; item += G) {
        const size_t row0 = (size_t)item * 128;
#pragma unroll
        for (int it = 0; it < 4; ++it) { const int tok = wave * 16 + it * 4 + fq; const bf16_t* zr = P + (row0 + tok) * NIN + 3072 + fr * 8; u32x4 w[8];
#pragma unroll
            for (int k = 0; k < 8; ++k) w[k] = *(const u32x4*)(zr + k * 128);
            float s = 0.f, s2 = 0.f;
#pragma unroll
            for (int k = 0; k < 8; ++k) { const float e[8] = {bflo(w[k].x), bfhi(w[k].x), bflo(w[k].y), bfhi(w[k].y), bflo(w[k].z), bfhi(w[k].z), bflo(w[k].w), bfhi(w[k].w)};
#pragma unroll
                for (int q = 0; q < 8; ++q) { s += e[q]; s2 += e[q] * e[q]; } }
#pragma unroll
            for (int o = 1; o < 16; o <<= 1) { s += __shfl_xor(s, o); s2 += __shfl_xor(s2, o); }
            const float mean = s * (1.f / DM), var = fmaxf(s2 * (1.f / DM) - mean * mean, 0.f);
            if (fr == 0) { mu[tok] = mean; rstd[tok] = rsqrtf(var + EPS); } }
        u32x4 tr[4];
#pragma unroll
        for (int i = 0; i < 4; ++i) tr[i] = *(const u32x4*)(P + (row0 + (tid >> 4) + 32 * i) * NIN + 3072 + c8);
        __syncthreads();
        for (int g = 0; g < 8; ++g) {
            { const f32x4 g0 = *(const f32x4*)(lng + g * 128 + c8), g1 = *(const f32x4*)(lng + g * 128 + c8 + 4), b0 = *(const f32x4*)(lnb + g * 128 + c8), b1 = *(const f32x4*)(lnb + g * 128 + c8 + 4);
#pragma unroll
              for (int i = 0; i < 4; ++i) { const int tok = (tid >> 4) + 32 * i; const float m = mu[tok], r = rstd[tok]; const u32x4 w = tr[i];
                  const f32x4 e0 = (f32x4){bflo(w.x), bfhi(w.x), bflo(w.y), bfhi(w.y)}, e1 = (f32x4){bflo(w.z), bfhi(w.z), bflo(w.w), bfhi(w.w)};
                  const f32x4 v0 = (e0 - m) * r * g0 + b0, v1 = (e1 - m) * r * g1 + b1;
                  u32x4 o; o.x = cvt_pk_bf16(v0[0], v0[1]); o.y = cvt_pk_bf16(v0[2], v0[3]); o.z = cvt_pk_bf16(v1[0], v1[1]); o.w = cvt_pk_bf16(v1[2], v1[3]);
                  *(u32x4*)(vr + tok * VTP + c8) = o; } }
            if (g < 7) {
#pragma unroll
                for (int i = 0; i < 4; ++i) tr[i] = *(const u32x4*)(P + (row0 + (tid >> 4) + 32 * i) * NIN + 3072 + (g + 1) * 128 + c8); }
            const int pt = 16 * wave + fr; bf16_t* ub = P + (row0 + pt) * NIN + 2048 + g * 128 + 4 * fq; u32x2 ur[8];
#pragma unroll
            for (int dt = 0; dt < 8; ++dt) ur[dt] = *(const u32x2*)(ub + 16 * dt);
            const bf16_t* Wsg = (const bf16_t*)(p->ws + OFF_WSG) + (size_t)(j * 8 + g) * 16384; bf16x8 wf[4];
#pragma unroll
            for (int ks = 0; ks < 4; ++ks) wf[ks] = *(const bf16x8*)(Wsg + (size_t)pt * 128 + 32 * ks + 8 * fq);
            const float sb = p->sg_b[(size_t)(j * 8 + g) * 128 + pt];
            __syncthreads();
            f32x4 acc[8];
#pragma unroll
            for (int dt = 0; dt < 8; ++dt) acc[dt] = (f32x4){0.f, 0.f, 0.f, 0.f};
            { v4i16_t lc[8], hc[8], ln[8], hn[8];
              { const bf16_t* vb = vr + (8 * fq + (fr >> 2)) * VTP + 4 * (fr & 3);
#pragma unroll
                for (int dt = 0; dt < 8; ++dt) { lc[dt] = __builtin_amdgcn_ds_read_tr16_b64_v4i16((LAS v4i16_t*)(vb + 16 * dt)); hc[dt] = __builtin_amdgcn_ds_read_tr16_b64_v4i16((LAS v4i16_t*)(vb + 4 * VTP + 16 * dt)); } }
              __builtin_amdgcn_sched_barrier(0);
#pragma unroll
              for (int ks = 0; ks < 4; ++ks) {
                  if (ks < 3) { const bf16_t* vb = vr + (32 * (ks + 1) + 8 * fq + (fr >> 2)) * VTP + 4 * (fr & 3);
#pragma unroll
                      for (int dt = 0; dt < 8; ++dt) { ln[dt] = __builtin_amdgcn_ds_read_tr16_b64_v4i16((LAS v4i16_t*)(vb + 16 * dt)); hn[dt] = __builtin_amdgcn_ds_read_tr16_b64_v4i16((LAS v4i16_t*)(vb + 4 * VTP + 16 * dt)); } }
                  __builtin_amdgcn_sched_barrier(0);
#pragma unroll
                  for (int dt = 0; dt < 8; ++dt) { const bf16x8 vf = (bf16x8){lc[dt][0], lc[dt][1], lc[dt][2], lc[dt][3], hc[dt][0], hc[dt][1], hc[dt][2], hc[dt][3]}; acc[dt] = __builtin_amdgcn_mfma_f32_16x16x32_bf16(vf, wf[ks], acc[dt], 0, 0, 0); }
                  __builtin_amdgcn_sched_barrier(0);
#pragma unroll
                  for (int dt = 0; dt < 8; ++dt) { lc[dt] = ln[dt]; hc[dt] = hn[dt]; } } }
#pragma unroll
            for (int dt = 0; dt < 8; ++dt) { const u32x2 uw = ur[dt];
                u32x2 o; o.x = cvt_pk_bf16(bflo(uw.x) * (acc[dt][0] + sb), bfhi(uw.x) * (acc[dt][1] + sb)); o.y = cvt_pk_bf16(bflo(uw.y) * (acc[dt][2] + sb), bfhi(uw.y) * (acc[dt][3] + sb));
                *(u32x2*)(ub + 16 * dt) = o; }
            __syncthreads();
        }
    }
}

constexpr int KLP = 72, VAP = 408, KROWS = 400;
__device__ __forceinline__ void attn_phase(KP p, int j, unsigned char* lds) {
    const int tid = tid_opaque(), lane = tid & 63, wave = tid >> 6, fr = lane & 15, fq = lane >> 4, G = gridDim.x;
    const bf16_t* QKV = (const bf16_t*)(p->ws + OFF_R1);
    bf16_t* AO = (bf16_t*)(p->ws + OFF_R1 + (size_t)MTOK * NQKV * 2);
    bf16_t* kl = (bf16_t*)lds;
    bf16_t* va = (bf16_t*)(lds + KROWS * KLP * 2);
    const float L2E = 1.4426950409f;
    for (int item = blockIdx.x; item < BATCH * 32 * 4; item += G) {
        const int kh = item & 3, qb = (item >> 2) & 31, b = item >> 7; const int qs = qb * 128, kpos0 = qs - 128; const size_t brow = (size_t)b * SEQ;
        { const bf16_t* VTb = (const bf16_t*)(p->ws + OFF_R1 + 160 * MiB) + ((size_t)b * 256 + kh * 64) * SEQ;
          u32x4 kreg[7], vreg[7];
#pragma unroll
          for (int it = 0; it < 7; ++it) { const int q = tid + 512 * it; kreg[it] = (u32x4){0u, 0u, 0u, 0u}; vreg[it] = kreg[it];
              if (q < KROWS * 8) { const int kk = q >> 3, d8 = (q & 7) * 8, kp = kpos0 + kk; if (kk < 384 && kp >= 0 && kp < SEQ) kreg[it] = *(const u32x4*)(QKV + (brow + kp) * NQKV + 1024 + kh * 64 + d8);
                  const int d = q / 50, k8 = (q - d * 50) * 8, vp = kpos0 + k8; if (k8 < 384 && vp >= 0 && vp < SEQ) vreg[it] = *(const u32x4*)(VTb + (size_t)d * SEQ + vp); } }
#pragma unroll
          for (int it = 0; it < 7; ++it) { const int q = tid + 512 * it;
              if (q < KROWS * 8) { const int kk = q >> 3, d8 = (q & 7) * 8; *(u32x4*)(kl + kk * KLP + d8) = kreg[it]; const int d = q / 50, k8 = (q - d * 50) * 8; *(u32x4*)(va + d * VAP + k8) = vreg[it]; } } }
        __syncthreads();
        const int hq = kh * 4 + (wave >> 1); const float sinkl = p->attn_sinks[j * 16 + hq] * L2E;
        const bool edge = (qb == 0) || (qb == 31);
        const bf16_t* qp0 = QKV + (brow + qs + (wave & 1) * 64 + fr) * NQKV + hq * 64 + 8 * fq;
        bf16x8 qn0 = *(const bf16x8*)qp0, qn1 = *(const bf16x8*)(qp0 + 32);
        for (int rt = 0; rt < 4; ++rt) {
            const int qi0 = (wave & 1) * 64 + 16 * rt, c0 = qi0 >> 4, qi = qi0 + fr;
            const bf16x8 qf0 = qn0, qf1 = qn1;
            if (rt < 3) { const bf16_t* qp = qp0 + (size_t)(16 * (rt + 1)) * NQKV; qn0 = *(const bf16x8*)qp; qn1 = *(const bf16x8*)(qp + 32); }
            f32x4 s[17];
            { bf16x8 kc[4][2], kn[4][2];
#pragma unroll
              for (int t = 0; t < 4; ++t) { const bf16_t* kp = kl + (16 * (c0 + t) + fr) * KLP + 8 * fq; kc[t][0] = *(const bf16x8*)kp; kc[t][1] = *(const bf16x8*)(kp + 32); }
              __builtin_amdgcn_sched_barrier(0);
#pragma unroll
              for (int g = 0; g < 5; ++g) {
#pragma unroll
                  for (int t = 0; t < 4; ++t) if (4 * (g + 1) + t < 17) { const bf16_t* kp = kl + (16 * (c0 + 4 * (g + 1) + t) + fr) * KLP + 8 * fq; kn[t][0] = *(const bf16x8*)kp; kn[t][1] = *(const bf16x8*)(kp + 32); }
                  __builtin_amdgcn_sched_barrier(0);
                  f32x4 h[4];
#pragma unroll
                  for (int t = 0; t < 4; ++t) if (4 * g + t < 17) h[t] = __builtin_amdgcn_mfma_f32_16x16x32_bf16(kc[t][0], qf0, (f32x4){0.f, 0.f, 0.f, 0.f}, 0, 0, 0);
#pragma unroll
                  for (int t = 0; t < 4; ++t) if (4 * g + t < 17) s[4 * g + t] = __builtin_amdgcn_mfma_f32_16x16x32_bf16(kc[t][1], qf1, h[t], 0, 0, 0);
                  __builtin_amdgcn_sched_barrier(0);
#pragma unroll
                  for (int t = 0; t < 4; ++t) { kc[t][0] = kn[t][0]; kc[t][1] = kn[t][1]; } } }
            if (edge) {
#pragma unroll
                for (int i = 0; i < 17; ++i)
#pragma unroll
                    for (int jj = 0; jj < 4; ++jj) { const int kk = 16 * (c0 + i) + 4 * fq + jj; const bool ok = (kk >= qi) && (kk <= qi + 256) && (kpos0 + kk >= 0) && (kpos0 + kk < SEQ); s[i][jj] = ok ? s[i][jj] : -1e30f; }
            } else {
#pragma unroll
                for (int jj = 0; jj < 4; ++jj) { s[0][jj] = (4 * fq + jj >= fr) ? s[0][jj] : -1e30f; s[16][jj] = (4 * fq + jj <= fr) ? s[16][jj] : -1e30f; }
            }
            float mx = -1e30f;
#pragma unroll
            for (int i = 0; i < 17; ++i) mx = fmaxf(fmaxf(mx, fmaxf(s[i][0], s[i][1])), fmaxf(s[i][2], s[i][3]));
            mx = fmaxf(mx, __shfl_xor(mx, 16)); mx = fmaxf(mx, __shfl_xor(mx, 32)); mx = fmaxf(mx, sinkl);
            float sum = 0.f;
#pragma unroll
            for (int i = 0; i < 17; ++i)
#pragma unroll
                for (int jj = 0; jj < 4; ++jj) { const float e = __builtin_amdgcn_exp2f(s[i][jj] - mx); s[i][jj] = e; sum += e; }
            sum += __shfl_xor(sum, 16); sum += __shfl_xor(sum, 32); sum += __builtin_amdgcn_exp2f(sinkl - mx);
            const float inv = 1.f / sum;
            f32x4 o[4];
#pragma unroll
            for (int dt = 0; dt < 4; ++dt) o[dt] = (f32x4){0.f, 0.f, 0.f, 0.f};
            { bf16x8 vc[4], vn[4];
#pragma unroll
              for (int dt = 0; dt < 4; ++dt) { const bf16_t* vp = va + (16 * dt + fr) * VAP + 16 * c0 + 4 * fq; const u32x2 lo = *(const u32x2*)vp, hi = *(const u32x2*)(vp + 16); vc[dt] = __builtin_bit_cast(bf16x8, (u32x4){lo.x, lo.y, hi.x, hi.y}); }
              __builtin_amdgcn_sched_barrier(0);
#pragma unroll
              for (int k2 = 0; k2 < 9; ++k2) {
                  if (k2 < 8) {
#pragma unroll
                      for (int dt = 0; dt < 4; ++dt) { const bf16_t* vp = va + (16 * dt + fr) * VAP + 16 * (c0 + 2 * (k2 + 1)) + 4 * fq; const u32x2 lo = *(const u32x2*)vp, hi = *(const u32x2*)(vp + 16); vn[dt] = __builtin_bit_cast(bf16x8, (u32x4){lo.x, lo.y, hi.x, hi.y}); } }
                  u32x4 pw; pw.x = cvt_pk_bf16(s[2 * k2][0], s[2 * k2][1]); pw.y = cvt_pk_bf16(s[2 * k2][2], s[2 * k2][3]);
                  if (k2 < 8) { pw.z = cvt_pk_bf16(s[(2 * k2 + 1) & 15][0], s[(2 * k2 + 1) & 15][1]); pw.w = cvt_pk_bf16(s[(2 * k2 + 1) & 15][2], s[(2 * k2 + 1) & 15][3]); } else { pw.z = 0u; pw.w = 0u; }
                  const bf16x8 pf = __builtin_bit_cast(bf16x8, pw);
                  __builtin_amdgcn_sched_barrier(0);
#pragma unroll
                  for (int dt = 0; dt < 4; ++dt) o[dt] = __builtin_amdgcn_mfma_f32_16x16x32_bf16(vc[dt], pf, o[dt], 0, 0, 0);
                  __builtin_amdgcn_sched_barrier(0);
#pragma unroll
                  for (int dt = 0; dt < 4; ++dt) vc[dt] = vn[dt]; } }
            bf16_t* op = AO + (brow + qs + qi) * DM + hq * 64 + 4 * fq;
#pragma unroll
            for (int dt = 0; dt < 4; ++dt) { u32x2 w; w.x = cvt_pk_bf16(o[dt][0] * inv, o[dt][1] * inv); w.y = cvt_pk_bf16(o[dt][2] * inv, o[dt][3] * inv); *(u32x2*)(op + 16 * dt) = w; }
        }
        __syncthreads();
    }
}

__device__ __forceinline__ void final_phase(KP p) {
    const int tid = tid_opaque(), lane = tid & 63, wave = tid >> 6, G = gridDim.x; const int gw = blockIdx.x * 8 + wave, NGW = G * 8;
    const float* ss = (const float*)(p->ws + OFF_SSP) + (size_t)8 * MTOK * 16; const bf16_t* xb = (const bf16_t*)(p->ws + OFF_XB);
    for (int m0 = gw; m0 < MTOK; m0 += 4 * NGW) { u32x2 w[4][4]; float rs[4];
#pragma unroll
        for (int r = 0; r < 4; ++r) { const int m = m0 + r * NGW; if (m < MTOK) { rs[r] = row_rs(ss, m); const u32x2* xr = (const u32x2*)(xb + (size_t)m * DM) + lane;
#pragma unroll
            for (int jj = 0; jj < 4; ++jj) w[r][jj] = xr[64 * jj]; } }
#pragma unroll
        for (int r = 0; r < 4; ++r) { const int m = m0 + r * NGW; if (m < MTOK) { f32x4* orow = (f32x4*)(p->out + (size_t)m * DM) + lane; const f32x4* gr = (const f32x4*)p->final_norm + lane;
#pragma unroll
            for (int jj = 0; jj < 4; ++jj) { const f32x4 v = (f32x4){bflo(w[r][jj].x), bfhi(w[r][jj].x), bflo(w[r][jj].y), bfhi(w[r][jj].y)}, g = gr[64 * jj]; orow[64 * jj] = v * rs[r] * g; } } } }
}

#define XB_TMO      128
#define XB_XCNT(j)  (256  + 64 * (j))
#define XB_XSUB(j)  (1280 + 64 * (j))
#define XB_XGEN(j)  (2304 + 64 * (j))
#define XB_TOP      3328
#define XB_TOPGEN   3392
#define XCD_BAR_WORDS 3456
#define XB_SPIN_CAP (1u << 22)
__device__ __forceinline__ unsigned xb_ld(unsigned* p)              { return __hip_atomic_load(p, __ATOMIC_RELAXED, __HIP_MEMORY_SCOPE_AGENT); }
__device__ __forceinline__ unsigned xb_add(unsigned* p, unsigned v) { return __hip_atomic_fetch_add(p, v, __ATOMIC_RELAXED, __HIP_MEMORY_SCOPE_AGENT); }
__device__ __forceinline__ unsigned xb_xcc_id() { return (unsigned)__builtin_amdgcn_s_getreg((3 << 11) | 20) & 0xFu; }
#define XB_SPIN(cond, bar) do { unsigned _sp = 0; while (cond) { __builtin_amdgcn_s_sleep(1); \
    if ((++_sp & 255u) == 0u) { if (xb_ld(&(bar)[XB_TMO])) break; if (_sp > XB_SPIN_CAP) { atomicAdd(&(bar)[XB_TMO], 1u); break; } } } } while (0)
__device__ __forceinline__ void xcd_barrier_complete(unsigned* bar, unsigned x, unsigned& nloc, unsigned& nx) {
    const unsigned G = gridDim.x * gridDim.y * gridDim.z;
    unsigned sum, cnt, mine, sp = 0u;
    for (;;) {
        sum = 0u; cnt = 0u; mine = 0u;
#pragma unroll
        for (unsigned j = 0; j < 16; ++j) { const unsigned c = xb_ld(&bar[XB_XCNT(j)]); sum += c; cnt += (c > 0u) ? 1u : 0u; mine = (j == x) ? c : mine; }
        if (sum == G) break;
        __builtin_amdgcn_s_sleep(1);
        if ((++sp & 255u) == 0u) { if (xb_ld(&bar[XB_TMO])) break; if (sp > XB_SPIN_CAP) { atomicAdd(&bar[XB_TMO], 1u); break; } }
    }
    nloc = mine > 0u ? mine : 1u; nx = cnt > 0u ? cnt : 1u;
}
__device__ __forceinline__ void xcd_barrier(unsigned* bar, volatile LAS unsigned* st) {
    asm volatile("s_waitcnt vmcnt(0)" ::: "memory");
    __syncthreads();
    if (threadIdx.x == 0) {
        const unsigned x = xb_xcc_id();
        __builtin_amdgcn_s_waitcnt(0);
        unsigned nloc = st[0], nx = st[1];
        if (nloc == 0u) { xcd_barrier_complete(bar, x, nloc, nx); st[0] = nloc; st[1] = nx; }
        const unsigned old = xb_add(&bar[XB_XSUB(x)], 1u);
        const unsigned gen = old / nloc;
        if (old + 1u == (gen + 1u) * nloc) {
            __builtin_amdgcn_fence(__ATOMIC_RELEASE, "agent");
            asm volatile("s_waitcnt vmcnt(0)" ::: "memory");
            const unsigned og = xb_add(&bar[XB_TOP], 1u);
            const unsigned tg = og / nx;
            if (og + 1u == (tg + 1u) * nx) xb_add(&bar[XB_TOPGEN], 1u);
            else XB_SPIN(xb_ld(&bar[XB_TOPGEN]) == tg, bar);
            __builtin_amdgcn_fence(__ATOMIC_ACQUIRE, "agent");
            xb_add(&bar[XB_XGEN(x)], 1u);
            asm volatile("s_waitcnt vmcnt(0)" ::: "memory");
        } else {
            XB_SPIN(xb_ld(&bar[XB_XGEN(x)]) == gen, bar);
            __builtin_amdgcn_fence(__ATOMIC_ACQUIRE, "agent");
            asm volatile("s_waitcnt vmcnt(0)" ::: "memory");
        }
    }
    __syncthreads();
}

__device__ __forceinline__ void run_phase(KP p, int ph, unsigned char* lds) {
    if (ph == 0) { prologue(p, lds); return; }
    if (ph == NPHASE - 1) { final_phase(p); return; }
    const int q = ph - 1; int layer, sub;
    if (q < 6) { layer = 0; sub = q; } else if (q < 11) { layer = 1; sub = q - 6; } else if (q < 17) { layer = 2; sub = q - 11; } else { layer = 3; sub = q - 17; }
    const int j = layer >> 1; const bool even = (layer & 1) == 0; const int nmix = even ? 4 : 3;
    unsigned char* ws = p->ws; float* ss = (float*)(ws + OFF_SSP); bf16_t* xb = (bf16_t*)(ws + OFF_XB); bf16_t* R1 = (bf16_t*)(ws + OFF_R1);
    LAS unsigned char* l3 = (LAS unsigned char*)lds;
    pg8::StaticOrder S;
    if (sub < nmix - 1) {
        if (even) {
            if (sub == 0) { pg8::Gemm g{xb, (const bf16_t*)(ws + OFF_WIN) + (size_t)j * NIN * DM, MTOK, NIN, DM, DM}; S.init(MTOK, NIN, gridDim.x, blockIdx.x);
                pg8::EpiIn E{R1, ss + (size_t)(2 * layer) * MTOK * 16}; pg8::gemm_phase<pg8::EpiIn>(l3, g, S, E); }
            else if (sub == 1) { lru_phase(p, j, 0, lds); sg_phase(p, j, lds); }
            else { lru_phase(p, j, 1, lds); }
        } else {
            if (sub == 0) { pg8::Gemm g{xb, (const bf16_t*)(ws + OFF_WQKV) + (size_t)j * NQKV * DM, MTOK, NQKV, DM, DM}; S.init(MTOK, NQKV, gridDim.x, blockIdx.x);
                pg8::EpiQKV E{R1, ss + (size_t)(2 * layer) * MTOK * 16, (const float*)(ws + OFF_ROPE), (bf16_t*)(ws + OFF_R1 + 160 * MiB)}; pg8::gemm_phase<pg8::EpiQKV>(l3, g, S, E); }
            else { attn_phase(p, j, lds); }
        }
        return;
    }
    if (sub == nmix) {
        pg8::Gemm g{xb, (const bf16_t*)(ws + OFF_WGU) + (size_t)layer * NGU * DM, MTOK, NGU, DM, DM}; S.init(MTOK, NGU, gridDim.x, blockIdx.x);
        pg8::EpiGU E{R1, ss + (size_t)(2 * layer + 1) * MTOK * 16}; pg8::gemm_phase<pg8::EpiGU>(l3, g, S, E);
        return;
    }
    pg8::Gemm g; float* ssn;
    if (sub == nmix - 1) {
        if (even) g = pg8::Gemm{R1 + DM, (const bf16_t*)(ws + OFF_WOUT) + (size_t)j * DM * KOUT, MTOK, DM, KOUT, NIN};
        else g = pg8::Gemm{R1 + (size_t)MTOK * NQKV, (const bf16_t*)(ws + OFF_WO) + (size_t)j * DM * DM, MTOK, DM, DM, DM};
        ssn = ss + (size_t)(2 * layer + 1) * MTOK * 16;
    } else {
        g = pg8::Gemm{R1, (const bf16_t*)(ws + OFF_WDN) + (size_t)layer * DM * DFF, MTOK, DM, DFF, DFF};
        ssn = ss + (size_t)(2 * layer + 2) * MTOK * 16;
    }
    S.init(MTOK, DM, gridDim.x, blockIdx.x);
    pg8::EpiRes E{xb, ssn}; pg8::gemm_phase<pg8::EpiRes>(l3, g, S, E);
}

__global__ void __launch_bounds__(512, 2) mega(Params pv) {
    extern __shared__ __attribute__((aligned(16))) unsigned char lds[];
    cg::grid_group grid = cg::this_grid();
    volatile LAS unsigned* st = (volatile LAS unsigned*)((LAS unsigned char*)lds + MISC_OFF);
    if (threadIdx.x < 2) st[threadIdx.x] = 0u;
    if (threadIdx.x == 0) (void)xb_add((unsigned*)(pv.ws + OFF_BAR) + XB_XCNT(xb_xcc_id()), 1u);
    __syncthreads();
    for (int ph = pv.ph_lo; ph < pv.ph_hi; ++ph) {
        KP p = (KP)__builtin_amdgcn_kernarg_segment_ptr(); asm volatile("" : "+s"(p));
        run_phase(p, ph, lds);
        if (ph + 1 < pv.ph_hi) { if (pv.ph_lo < 0) grid.sync(); else xcd_barrier((unsigned*)(p->ws + OFF_BAR), st); }
    }
}

extern "C" void kernel_launch(void* const* d_in, const int* in_sizes, int n_in, void* d_out, int out_size, void* d_ws, size_t ws_size, hipStream_t stream) {
    static int grid = 0;
    if (grid == 0) {
        if (n_in != 22 || ws_size < WS_NEED) { fprintf(stderr, "kernel_launch: unexpected n_in %d or ws_size %zu (< %zu)\n", n_in, ws_size, (size_t)WS_NEED); grid = -1; return; }
        int dev = 0, cus = 0, per_cu = 0;
        hipGetDevice(&dev); hipDeviceGetAttribute(&cus, hipDeviceAttributeMultiprocessorCount, dev);
        if (hipFuncSetAttribute((const void*)mega, hipFuncAttributeMaxDynamicSharedMemorySize, LDS_BYTES) != hipSuccess) { fprintf(stderr, "kernel_launch: hipFuncSetAttribute failed\n"); grid = -1; return; }
        if (hipOccupancyMaxActiveBlocksPerMultiprocessor(&per_cu, (const void*)mega, 512, LDS_BYTES) != hipSuccess || per_cu < 1) { fprintf(stderr, "kernel_launch: occupancy query gave %d\n", per_cu); per_cu = 1; }
        (void)hipGetLastError();
        grid = cus * 1;
    }
    if (grid < 0) return;
    if (hipMemsetAsync((char*)d_ws + OFF_BAR, 0, 16384, stream) != hipSuccess) { fprintf(stderr, "kernel_launch: memset failed\n"); return; }
    Params p{};
    const float** f = (const float**)&p;
    for (int i = 0; i < 22; ++i) f[i] = (const float*)d_in[i];
    p.out = (float*)d_out; p.ws = (unsigned char*)d_ws;
    p.ph_lo = 0; p.ph_hi = NPHASE;
    void* args[] = {&p};
    hipError_t e = hipLaunchCooperativeKernel((const void*)mega, dim3(grid), dim3(512), args, LDS_BYTES, stream);
    if (e != hipSuccess) fprintf(stderr, "cooperative launch failed: %s (grid %d)\n", hipGetErrorString(e), grid);
}
```
